# Optimizing an MI355X kernel written in HIP

```python
import jax
import jax.numpy as jnp
from jax import lax
import numpy as np

D_MODEL = 1024
BATCH = 8
SEQ = 4096
DEPTH = 1

EPS = 1e-6
N_MEM = 256
Q_BLOCK = 128

A_HEADS = 8
A_HEAD_DIM = 64
A_WIDTH = A_HEADS * A_HEAD_DIM
DILATED_BRANCHES = ((128, 1), (512, 4), (2048, 16))

B_HEADS = 4
B_NOPE = 128
B_ROPE = 64
B_V = 128
B_WIDTH = B_HEADS * B_V
Q_LORA = 384
KV_LORA = 256
ROPE_THETA = 10000.0

MIX_WIDTH = A_WIDTH + B_WIDTH
IN_SPLITS = (A_WIDTH, A_WIDTH, A_WIDTH, Q_LORA, KV_LORA, B_ROPE)
D_IN = sum(IN_SPLITS)
SPLIT_POINTS = tuple(sum(IN_SPLITS[:i + 1]) for i in range(len(IN_SPLITS) - 1))

M_HEADS = 4
M_HEAD_DIM = 128
M_WIDTH = M_HEADS * M_HEAD_DIM

D_FF = -(-8 * D_MODEL // (3 * 256)) * 256

kernel_name = 'hymba_dilated_mla_memory_encoder'


def rms_norm(x, g):
    xf = x.astype(jnp.float32)
    y = xf * lax.rsqrt(jnp.mean(xf * xf, axis=-1, keepdims=True) + EPS)
    return (y * g.astype(jnp.float32)).astype(x.dtype)


def alibi_slopes(n):
    return 2.0 ** (-8.0 * jnp.arange(1, n + 1, dtype=jnp.float32) / n)


def apply_rope(t, cos, sin):
    tf = t.astype(jnp.float32)
    t1, t2 = jnp.split(tf, 2, axis=-1)
    return jnp.concatenate([t1 * cos - t2 * sin, t2 * cos + t1 * sin], axis=-1).astype(t.dtype)


def dilated_attention(q, k, v, positions):
    S = q.shape[1]
    scale = A_HEAD_DIM ** -0.5
    slopes = alibi_slopes(A_HEADS)

    def block(start):
        t = start + jnp.arange(Q_BLOCK)
        qb = lax.dynamic_slice_in_dim(q, start, Q_BLOCK, axis=1)
        pq = lax.dynamic_slice_in_dim(positions, start, Q_BLOCK, axis=1)
        outs, lses = [], []
        for window, dil in DILATED_BRANCHES:
            n = window // (2 * dil)
            offs = jnp.arange(-n, n + 1) * dil
            idx = t[:, None] + offs[None, :]
            valid = (idx >= 0) & (idx < S)
            idx = jnp.clip(idx, 0, S - 1)
            kg = k[:, idx]
            vg = v[:, idx]
            pk = positions[:, idx]
            dist = jnp.abs(pq[:, :, None] - pk).astype(jnp.float32)
            s = jnp.einsum('bqhd,bqkhd->bhqk', qb, kg).astype(jnp.float32) * scale
            s = s - slopes[None, :, None, None] * dist[:, None]
            s = jnp.where(valid[None, None], s, -jnp.inf)
            lse = jax.nn.logsumexp(s, axis=-1)
            p = jnp.exp(s - lse[..., None]).astype(v.dtype)
            outs.append(jnp.einsum('bhqk,bqkhd->bqhd', p, vg))
            lses.append(lse)
        alpha = jax.nn.softmax(jnp.stack(lses), axis=0)
        alpha = jnp.transpose(alpha, (0, 1, 3, 2))[..., None]
        o = jnp.sum(alpha * jnp.stack(outs).astype(jnp.float32), axis=0)
        return o.astype(q.dtype)

    starts = jnp.arange(S // Q_BLOCK) * Q_BLOCK
    o = lax.map(block, starts)
    return jnp.moveaxis(o, 0, 1).reshape(q.shape)


def dense_attention(q, k, v, scale):
    S = q.shape[1]

    def block(start):
        qb = lax.dynamic_slice_in_dim(q, start, Q_BLOCK, axis=1)
        s = jnp.einsum('bqhd,bkhd->bhqk', qb, k).astype(jnp.float32) * scale
        p = jax.nn.softmax(s, axis=-1).astype(v.dtype)
        return jnp.einsum('bhqk,bkhd->bqhd', p, v)

    starts = jnp.arange(S // Q_BLOCK) * Q_BLOCK
    o = lax.map(block, starts)
    return jnp.moveaxis(o, 0, 1).reshape(q.shape[:3] + (v.shape[-1],))


def setup_inputs(seed: int = 0) -> dict:
    key = jax.random.key(seed)
    ks = jax.random.split(key, 24)

    def dense(k, fan_in, fan_out):
        return jax.random.normal(k, (DEPTH, fan_in, fan_out), jnp.float32) * fan_in ** -0.5

    def gain(k, n):
        return 1.0 + 0.02 * jax.random.normal(k, (DEPTH, n), jnp.float32)

    x = jax.random.normal(ks[0], (BATCH, SEQ, D_MODEL), jnp.float32)
    mem = jax.random.normal(ks[1], (BATCH, N_MEM, D_MODEL), jnp.float32)
    offset = jax.random.randint(ks[2], (BATCH, 1), 0, 1024, dtype=jnp.int32)
    positions = jnp.arange(SEQ, dtype=jnp.int32)[None, :] + offset
    return {
        'x': x,
        'mem': mem,
        'positions': positions,
        'norm_mix': gain(ks[3], D_MODEL),
        'w_in': dense(ks[4], D_MODEL, D_IN),
        'q_norm': gain(ks[5], Q_LORA),
        'w_q_up': dense(ks[6], Q_LORA, B_HEADS * (B_NOPE + B_ROPE)),
        'kv_norm': gain(ks[7], KV_LORA),
        'w_kv_up': dense(ks[8], KV_LORA, B_HEADS * (B_NOPE + B_V)),
        'gout_a': gain(ks[9], A_WIDTH),
        'gout_b': gain(ks[10], B_WIDTH),
        'w_out': dense(ks[11], MIX_WIDTH, D_MODEL),
        'norm_mem_q': gain(ks[12], D_MODEL),
        'norm_mem_kv': gain(ks[13], D_MODEL),
        'w_mq': dense(ks[14], D_MODEL, M_WIDTH),
        'w_mkv': dense(ks[15], D_MODEL, 2 * M_WIDTH),
        'w_mo': dense(ks[16], M_WIDTH, D_MODEL),
        'norm_ffn': gain(ks[17], D_MODEL),
        'w_gate': dense(ks[18], D_MODEL, D_FF),
        'w_up': dense(ks[19], D_MODEL, D_FF),
        'w_down': dense(ks[20], D_FF, D_MODEL),
        'norm_final': 1.0 + 0.02 * jax.random.normal(ks[21], (D_MODEL,), jnp.float32),
    }


def reference(x, mem, positions, norm_mix, w_in, q_norm, w_q_up, kv_norm, w_kv_up,
              gout_a, gout_b, w_out, norm_mem_q, norm_mem_kv, w_mq, w_mkv, w_mo,
              norm_ffn, w_gate, w_up, w_down, norm_final):
    B, S = x.shape[0], x.shape[1]
    M = mem.shape[1]
    half = B_ROPE // 2
    inv_freq = ROPE_THETA ** (-jnp.arange(half, dtype=jnp.float32) / half)
    ang = positions.astype(jnp.float32)[..., None] * inv_freq
    cos, sin = jnp.cos(ang), jnp.sin(ang)

    for l in range(DEPTH):
        h = rms_norm(x, norm_mix[l])
        proj = h @ w_in[l]
        qa, ka, va, cq, ckv, kr = jnp.split(proj, SPLIT_POINTS, axis=-1)

        hs_a = (B, S, A_HEADS, A_HEAD_DIM)
        o_a = dilated_attention(qa.reshape(hs_a), ka.reshape(hs_a), va.reshape(hs_a), positions)
        o_a = o_a.reshape(B, S, A_WIDTH)

        qb = (rms_norm(cq, q_norm[l]) @ w_q_up[l]).reshape(B, S, B_HEADS, B_NOPE + B_ROPE)
        q_nope, q_pe = jnp.split(qb, [B_NOPE], axis=-1)
        q_pe = apply_rope(q_pe, cos[:, :, None, :], sin[:, :, None, :])
        kvb = (rms_norm(ckv, kv_norm[l]) @ w_kv_up[l]).reshape(B, S, B_HEADS, B_NOPE + B_V)
        k_nope, v_b = jnp.split(kvb, [B_NOPE], axis=-1)
        k_pe = apply_rope(kr, cos, sin)
        k_pe = jnp.broadcast_to(k_pe[:, :, None, :], (B, S, B_HEADS, B_ROPE))
        q_b = jnp.concatenate([q_nope, q_pe], axis=-1)
        k_b = jnp.concatenate([k_nope, k_pe], axis=-1)
        o_b = dense_attention(q_b, k_b, v_b, (B_NOPE + B_ROPE) ** -0.5).reshape(B, S, B_WIDTH)

        mixed = jnp.concatenate([rms_norm(o_a, gout_a[l]), rms_norm(o_b, gout_b[l])], axis=-1)
        x = x + mixed @ w_out[l]

        hq = rms_norm(x, norm_mem_q[l])
        mk = rms_norm(mem, norm_mem_kv[l])
        mq = (hq @ w_mq[l]).reshape(B, S, M_HEADS, M_HEAD_DIM)
        mkv = (mk @ w_mkv[l]).reshape(B, M, 2, M_HEADS, M_HEAD_DIM)
        mkk, mvv = mkv[:, :, 0], mkv[:, :, 1]
        s = jnp.einsum('bshd,bmhd->bhsm', mq, mkk).astype(jnp.float32) * M_HEAD_DIM ** -0.5
        p = jax.nn.softmax(s, axis=-1).astype(mvv.dtype)
        mo = jnp.einsum('bhsm,bmhd->bshd', p, mvv).reshape(B, S, M_WIDTH)
        x = x + mo @ w_mo[l]

        hf = rms_norm(x, norm_ffn[l])
        x = x + (jax.nn.silu(hf @ w_gate[l]) * (hf @ w_up[l])) @ w_down[l]

    return rms_norm(x, norm_final)
```

```cpp
#include <hip/hip_runtime.h>
#include <hip/hip_cooperative_groups.h>
#include <cstdio>
#include <cstdint>
namespace cg = cooperative_groups;
#define DI __device__ __forceinline__
__device__ __forceinline__ int opaque_tid() { int t = threadIdx.x; asm volatile("" : "+v"(t)); return t; }

namespace pg8 {
#define PG8_LAS __attribute__((address_space(3)))
typedef unsigned short bf16_t;
typedef short bf16x8 __attribute__((ext_vector_type(8)));
typedef float f32x4 __attribute__((ext_vector_type(4)));
typedef unsigned u32x4 __attribute__((ext_vector_type(4)));
constexpr int BM = 256, BK = 64, HALF = 128, HTB = HALF * BK * 2  , STAGE_BYTES = 8 * HTB, NXCD = 8, WGM = 8;

__host__ __device__ __forceinline__ int lds_byte(int r, int c) { const int st = (r >> 4) * 2 + (c >> 5), rr = r & 15, cc = c & 31, ob = rr * 64 + cc * 2; return st * 1024 + (ob ^ (((ob >> 9) & 1) << 5)); }
__host__ __device__ __forceinline__ void stage_rc(int b, int& R, int& C) { const int st = b / 1024, sb = b % 1024, swz = sb ^ (((sb >> 9) & 1) << 5); R = (st >> 1) * 16 + swz / 64; C = (st & 1) * 32 + (swz % 64) / 2; }
__host__ __device__ __forceinline__ int perm32(int rho) { const int n = rho >> 4, i = rho & 15; return 8 * (i >> 2) + 4 * n + (i & 3); }

struct Unit { int pm, pn; };
struct Gemm { const bf16_t* A; const bf16_t* Bt; int M, N, K; };

struct StaticOrder {
    int nM, nN, nwg, G, c;
    __host__ __device__ void init(int M, int N, int G_, int c_) { nM = M / BM; nN = N / BM; nwg = nM * nN; G = G_; c = c_; }
    __host__ __device__ bool next(int i, Unit& u) const {
        const long L = (long)i * G + c; if (L >= nwg) return false;
        int wgid = (int)L; { const int q = nwg / NXCD, r = nwg % NXCD, xcd = wgid % NXCD, off = wgid / NXCD; wgid = (xcd < r ? xcd * (q + 1) : r * (q + 1) + (xcd - r) * q) + off; }
        const int nig = WGM * nN, gid = wgid / nig, fm = gid * WGM, gsz = (nM - fm) < WGM ? (nM - fm) : WGM;
        u.pm = fm + ((wgid % nig) % gsz); u.pn = (wgid % nig) / gsz; return true;
    }
    __device__ __forceinline__ void a_ready(const Unit&) const {}
    __device__ __forceinline__ void done(const Unit&) const {}
};

typedef unsigned u32x2 __attribute__((ext_vector_type(2)));
__device__ __forceinline__ unsigned cvt_pk_bf16(float lo, float hi) { unsigned r; asm("v_cvt_pk_bf16_f32 %0, %1, %2" : "=v"(r) : "v"(lo), "v"(hi)); return r; }
template <class Epi, class Sched, bool ALIGN_EPI = false, bool SP2 = false>
__device__ __forceinline__ void gemm_phase(PG8_LAS unsigned char* lds, const Gemm g, const Sched& S, const Epi& E) {
    const int tid = opaque_tid(), wid = __builtin_amdgcn_readfirstlane(tid >> 6), lane = tid & 63, wr = wid >> 2, wc = wid & 3, fr = lane & 15, fq = lane >> 4;
    const int K = g.K, nt = K / BK;
    unsigned voffA[2], voffB[2];
#pragma unroll
    for (int i = 0; i < 2; ++i) { int R, C; stage_rc(tid * 16 + i * 8192, R, C); const int Rb = Epi::PERM ? ((R & ~31) + perm32(R & 31)) : R;
        voffA[i] = (unsigned)(R * K + C) * 2u; voffB[i] = (unsigned)(Rb * K + C) * 2u; }
    const size_t kstep = (size_t)(BK * 2);
    const size_t hstep = (size_t)HALF * K * 2;
    const size_t tstep = 2 * hstep;
    const unsigned ldsw = (unsigned)wid * 1024u;
    const int aoff = lds_byte(wr * 64 + fr, fq * 8), boff = lds_byte(wc * 32 + fr, fq * 8);
#define PG8_SA(b, h) (((b) * 2 + (h)) * HTB)
#define PG8_SB(b, h) ((4 + (b) * 2 + (h)) * HTB)
#define PG8_STAGE(bufoff, gbase, voff) do { _Pragma("unroll") for (int _i = 0; _i < 2; ++_i) \
        __builtin_amdgcn_global_load_lds((const unsigned*)((const char*)(gbase) + (voff)[_i]), (PG8_LAS unsigned*)(lds + (bufoff) + ldsw + _i * 8192), 16, 0, 0); } while (0)
#define PG8_LDA(dst, b, h) do { _Pragma("unroll") for (int m = 0; m < 4; ++m) _Pragma("unroll") for (int k = 0; k < 2; ++k) dst[m][k] = *(const PG8_LAS bf16x8*)(lds + PG8_SA(b, h) + aoff + m * 2048 + k * 1024); } while (0)
#define PG8_LDB(dst, b, h) do { _Pragma("unroll") for (int n = 0; n < 2; ++n) _Pragma("unroll") for (int k = 0; k < 2; ++k) dst[n][k] = *(const PG8_LAS bf16x8*)(lds + PG8_SB(b, h) + boff + n * 2048 + k * 1024); } while (0)
#define PG8_MMA(ai, bj, At, Bt) do { __builtin_amdgcn_s_setprio(1); _Pragma("unroll") for (int m = 0; m < 4; ++m) _Pragma("unroll") for (int n = 0; n < 2; ++n) _Pragma("unroll") for (int k = 0; k < 2; ++k) \
        acc[ai][bj][m][n] = __builtin_amdgcn_mfma_f32_16x16x32_bf16(Bt[n][k], At[m][k], acc[ai][bj][m][n], 0, 0, 0); __builtin_amdgcn_s_setprio(0); } while (0)
#define PG8_WAIT_V(n) asm volatile("s_waitcnt vmcnt(" #n ")" ::: "memory")
#define PG8_WAIT_L(n) asm volatile("s_waitcnt lgkmcnt(" #n ")" ::: "memory")
#define PG8_BAR __builtin_amdgcn_s_barrier()
#define PG8_SCHED __builtin_amdgcn_sched_barrier(0)
    Unit cur, nxt; int ui = 0;
    if (!S.next(0, cur)) return;
    f32x4 acc[2][2][4][2];
#pragma unroll
    for (int a = 0; a < 2; ++a)
#pragma unroll
        for (int b = 0; b < 2; ++b)
#pragma unroll
            for (int m = 0; m < 4; ++m)
#pragma unroll
                for (int n = 0; n < 2; ++n) acc[a][b][m][n] = (f32x4){0.f, 0.f, 0.f, 0.f};
    bf16x8 At[4][2], B0[2][2], B1[2][2];
    const char* cA = (const char*)g.A + (size_t)cur.pm * tstep; const char* cB = (const char*)g.Bt + (size_t)cur.pn * tstep;
    S.a_ready(cur);
    if constexpr (SP2) {
        PG8_STAGE(PG8_SB(0, 0), cB, voffB); PG8_STAGE(PG8_SB(0, 1), cB + hstep, voffB); PG8_STAGE(PG8_SA(0, 0), cA, voffA); PG8_STAGE(PG8_SA(0, 1), cA + hstep, voffA);
        if (wr == 1) PG8_BAR;
        PG8_WAIT_V(2); PG8_BAR;
        PG8_STAGE(PG8_SB(1, 0), cB + kstep, voffB); PG8_STAGE(PG8_SA(1, 0), cA + kstep, voffA); PG8_STAGE(PG8_SB(1, 1), cB + hstep + kstep, voffB);
        PG8_WAIT_V(6); PG8_BAR;
    } else {
        PG8_STAGE(PG8_SB(0, 0), cB, voffB); PG8_STAGE(PG8_SA(0, 0), cA, voffA); PG8_STAGE(PG8_SB(0, 1), cB + hstep, voffB); PG8_STAGE(PG8_SA(0, 1), cA + hstep, voffA);
        if (wr == 1) PG8_BAR;
        PG8_WAIT_V(4); PG8_BAR;
        PG8_STAGE(PG8_SB(1, 0), cB + kstep, voffB); PG8_STAGE(PG8_SA(1, 0), cA + kstep, voffA); PG8_STAGE(PG8_SB(1, 1), cB + hstep + kstep, voffB);
        PG8_WAIT_V(6); PG8_BAR;
    }
    for (;;) {
        const bool has_next = S.next(ui + 1, nxt);
        const char* nA = has_next ? (const char*)g.A + (size_t)nxt.pm * tstep : cA; const char* nB = has_next ? (const char*)g.Bt + (size_t)nxt.pn * tstep : cB;
#pragma unroll 1
        for (int t = 0; t < nt; t += 2) {
            const bool last = (t == nt - 2);
            const char* a1 = cA + (size_t)(t + 1) * kstep;
            const char* a2 = last ? nA : cA + (size_t)(t + 2) * kstep; const char* b2 = last ? nB : cB + (size_t)(t + 2) * kstep;
            const char* a3 = a2 + kstep; const char* b3 = b2 + kstep;
            if (last && has_next) S.a_ready(nxt);
            if constexpr (SP2) {
            PG8_LDB(B0, 0, 0); PG8_LDB(B1, 0, 1); PG8_SCHED; PG8_LDA(At, 0, 0); PG8_STAGE(PG8_SA(1, 1), a1 + hstep, voffA);
            PG8_WAIT_V(8); PG8_WAIT_L(0); PG8_BAR; PG8_MMA(0, 0, At, B0); PG8_MMA(0, 1, At, B1); PG8_BAR; PG8_SCHED;
            PG8_LDA(At, 0, 1); PG8_STAGE(PG8_SB(0, 0), b2, voffB); PG8_STAGE(PG8_SB(0, 1), b2 + hstep, voffB); PG8_STAGE(PG8_SA(0, 0), a2, voffA);
            PG8_WAIT_V(8); PG8_WAIT_L(0); PG8_BAR; PG8_MMA(1, 0, At, B0); PG8_MMA(1, 1, At, B1); PG8_BAR; PG8_SCHED;
            PG8_LDB(B0, 1, 0); PG8_LDB(B1, 1, 1); PG8_SCHED; PG8_LDA(At, 1, 0); PG8_STAGE(PG8_SA(0, 1), a2 + hstep, voffA);
            PG8_WAIT_V(8); PG8_WAIT_L(0); PG8_BAR; PG8_MMA(0, 0, At, B0); PG8_MMA(0, 1, At, B1); PG8_BAR; PG8_SCHED;
            PG8_LDA(At, 1, 1); PG8_STAGE(PG8_SB(1, 0), b3, voffB); PG8_STAGE(PG8_SB(1, 1), b3 + hstep, voffB); PG8_STAGE(PG8_SA(1, 0), a3, voffA);
            PG8_WAIT_V(8); PG8_WAIT_L(0); PG8_BAR; PG8_MMA(1, 0, At, B0); PG8_MMA(1, 1, At, B1); PG8_BAR; PG8_SCHED;
            } else {
            PG8_LDB(B0, 0, 0); PG8_SCHED; PG8_LDA(At, 0, 0); PG8_STAGE(PG8_SA(1, 1), a1 + hstep, voffA);
            PG8_WAIT_L(8); PG8_BAR; PG8_WAIT_L(0); PG8_MMA(0, 0, At, B0); PG8_BAR; PG8_SCHED;
            PG8_LDB(B1, 0, 1); PG8_STAGE(PG8_SB(0, 0), b2, voffB);
            PG8_BAR; PG8_WAIT_L(0); PG8_MMA(0, 1, At, B1); PG8_BAR;
            PG8_LDA(At, 0, 1); PG8_STAGE(PG8_SA(0, 0), a2, voffA);
            PG8_BAR; PG8_WAIT_L(0); PG8_MMA(1, 0, At, B0); PG8_BAR; PG8_SCHED;
            PG8_STAGE(PG8_SB(0, 1), b2 + hstep, voffB);
            PG8_WAIT_V(6); PG8_BAR; PG8_MMA(1, 1, At, B1); PG8_BAR;
            PG8_LDB(B0, 1, 0); PG8_SCHED; PG8_LDA(At, 1, 0); PG8_STAGE(PG8_SA(0, 1), a2 + hstep, voffA);
            PG8_WAIT_L(8); PG8_BAR; PG8_WAIT_L(0); PG8_MMA(0, 0, At, B0); PG8_BAR; PG8_SCHED;
            PG8_LDB(B1, 1, 1); PG8_STAGE(PG8_SB(1, 0), b3, voffB);
            PG8_BAR; PG8_WAIT_L(0); PG8_MMA(0, 1, At, B1); PG8_BAR;
            PG8_LDA(At, 1, 1); PG8_STAGE(PG8_SA(1, 0), a3, voffA);
            PG8_BAR; PG8_WAIT_L(0); PG8_MMA(1, 0, At, B0); PG8_BAR; PG8_SCHED;
            PG8_STAGE(PG8_SB(1, 1), b3 + hstep, voffB);
            PG8_WAIT_V(6); PG8_BAR; PG8_MMA(1, 1, At, B1); PG8_BAR;
            }
        }
        if constexpr (ALIGN_EPI) { if (wr == 0) PG8_BAR; }
        if constexpr (!Epi::AFTER_DRAIN) { E(acc, cur, wr, wc, fr, fq); S.done(cur); }
        if (!has_next) break;
#pragma unroll
        for (int a = 0; a < 2; ++a)
#pragma unroll
            for (int b = 0; b < 2; ++b)
#pragma unroll
                for (int m = 0; m < 4; ++m)
#pragma unroll
                    for (int n = 0; n < 2; ++n) acc[a][b][m][n] = (f32x4){0.f, 0.f, 0.f, 0.f};
        cur = nxt; cA = nA; cB = nB; ++ui;
        if constexpr (ALIGN_EPI) { if (wr == 1) PG8_BAR; }
    }
    PG8_WAIT_V(0);
    if constexpr (!ALIGN_EPI) { if (wr == 0) PG8_BAR; }
    PG8_BAR;
    if constexpr (Epi::AFTER_DRAIN) { E.fused(acc, cur, wr, wc, fr, fq, lds, wid, lane); S.done(cur); }
#undef PG8_SA
#undef PG8_SB
#undef PG8_STAGE
#undef PG8_LDA
#undef PG8_LDB
#undef PG8_MMA
#undef PG8_WAIT_V
#undef PG8_WAIT_L
#undef PG8_BAR
#undef PG8_SCHED
}
}

constexpr int NB = 8, SEQ = 4096, DM = 1024, T = NB * SEQ, NMEM = 256, TM = NB * NMEM;
constexpr int DIN_PAD = 2304, QLORA = 384, KVLORA = 256, DFF = 2816;
constexpr float EPS = 1e-6f;
typedef unsigned short bf16;
typedef short bf16x8 __attribute__((ext_vector_type(8)));
typedef short s16x4 __attribute__((ext_vector_type(4)));
typedef float f32x4 __attribute__((ext_vector_type(4)));
typedef float f32x16 __attribute__((ext_vector_type(16)));
typedef unsigned u32x4 __attribute__((ext_vector_type(4)));
typedef unsigned u32x2 __attribute__((ext_vector_type(2)));
#define LAS __attribute__((address_space(3)))

namespace epi {
using pg8::Unit; using pg8::cvt_pk_bf16;
DI u32x4 pack8(const f32x4 v0, const f32x4 v1) { u32x4 w; w.x = cvt_pk_bf16(v0[0], v0[1]); w.y = cvt_pk_bf16(v0[2], v0[3]); w.z = cvt_pk_bf16(v1[0], v1[1]); w.w = cvt_pk_bf16(v1[2], v1[3]); return w; }
DI float sq8(const f32x4 a, const f32x4 b) { return (a[0]*a[0] + a[1]*a[1]) + (a[2]*a[2] + a[3]*a[3]) + (b[0]*b[0] + b[1]*b[1]) + (b[2]*b[2] + b[3]*b[3]); }

struct Plain {
    static constexpr bool PERM = true, AFTER_DRAIN = false;
    bf16* O; int ldc;
    DI void operator()(const f32x4 (&acc)[2][2][4][2], const Unit& u, int wr, int wc, int fr, int fq) const {
        const int row0 = u.pm * 256 + wr * 64 + fr, col0 = u.pn * 256 + wc * 32 + 8 * fq;
#pragma unroll
        for (int ai = 0; ai < 2; ++ai)
#pragma unroll
            for (int m = 0; m < 4; ++m) { bf16* rowp = O + (size_t)(row0 + ai * 128 + m * 16) * ldc + col0;
#pragma unroll
                for (int bj = 0; bj < 2; ++bj) *(u32x4*)(rowp + bj * 128) = pack8(acc[ai][bj][m][0], acc[ai][bj][m][1]); }
    }
};
struct Proj {
    static constexpr bool PERM = true, AFTER_DRAIN = false;
    bf16 *QKV, *CQ, *CKV, *KPE; float* SSQ; const float *TC, *TS;
    DI void operator()(const f32x4 (&acc)[2][2][4][2], const Unit& u, int wr, int wc, int fr, int fq) const {
        const int row0 = u.pm * 256 + wr * 64 + fr, lc = wc * 32 + 8 * fq;
        if (u.pn < 6) {
#pragma unroll
            for (int ai = 0; ai < 2; ++ai)
#pragma unroll
                for (int m = 0; m < 4; ++m) { const int grow = row0 + ai * 128 + m * 16, bb = grow >> 12, tt = grow & 4095;
#pragma unroll
                    for (int bj = 0; bj < 2; ++bj) { const int hh = (u.pn & 1) * 4 + bj * 2 + (wc >> 1);
                        __builtin_nontemporal_store(pack8(acc[ai][bj][m][0], acc[ai][bj][m][1]), (u32x4*)(QKV + ((size_t)(((u.pn >> 1) * NB + bb) * 8 + hh) * SEQ + tt) * 64 + (wc & 1) * 32 + 8 * fq)); } }
            return;
        }
#pragma unroll
        for (int ai = 0; ai < 2; ++ai)
#pragma unroll
            for (int m = 0; m < 4; ++m) {
                const size_t row = (size_t)(row0 + ai * 128 + m * 16);
                if (u.pn == 8 && wc >= 2) {
                    if (wc == 2) {
                        const f32x4 c0 = *(const f32x4*)(TC + row * 32 + 8 * fq), c1 = *(const f32x4*)(TC + row * 32 + 8 * fq + 4);
                        const f32x4 s0 = *(const f32x4*)(TS + row * 32 + 8 * fq), s1 = *(const f32x4*)(TS + row * 32 + 8 * fq + 4);
                        const f32x4 a0 = acc[ai][0][m][0], a1 = acc[ai][0][m][1], b0 = acc[ai][1][m][0], b1 = acc[ai][1][m][1];
                        *(u32x4*)(KPE + row * 64 + 8 * fq) = pack8(a0 * c0 - b0 * s0, a1 * c1 - b1 * s1);
                        *(u32x4*)(KPE + row * 64 + 32 + 8 * fq) = pack8(b0 * c0 + a0 * s0, b1 * c1 + a1 * s1);
                    }
                    continue;
                }
#pragma unroll
                for (int bj = 0; bj < 2; ++bj) {
                    const f32x4 v0 = acc[ai][bj][m][0], v1 = acc[ai][bj][m][1];
                    bf16* dst; int slot;
                    if (u.pn == 6)      { dst = CQ + row * 384 + bj * 128 + lc; slot = 4 * bj + wc; }
                    else if (u.pn == 7) { if (bj == 0) { dst = CQ + row * 384 + 256 + lc; slot = 8 + wc; } else { dst = CKV + row * 256 + lc; slot = 12 + wc; } }
                    else                { dst = CKV + row * 256 + 128 + 64 * bj + lc; slot = 16 + 2 * bj + wc; }
                    *(u32x4*)dst = pack8(v0, v1);
                    float s = sq8(v0, v1); s += __shfl_xor(s, 16); s += __shfl_xor(s, 32);
                    if (fq == 0) unsafeAtomicAdd(SSQ + row * 2 + (slot >= 12 ? 1 : 0), s);
                }
            }
    }
};
template <int SLOT0, int NQ, int KDIM, int LDS_ = 32> struct Scaled {
    static constexpr bool PERM = true, AFTER_DRAIN = false;
    bf16* O; int ldc; const float* SSQ;
    DI void operator()(const f32x4 (&acc)[2][2][4][2], const Unit& u, int wr, int wc, int fr, int fq) const {
        const int row0 = u.pm * 256 + wr * 64 + fr, col0 = u.pn * 256 + wc * 32 + 8 * fq;
        float ssv[8];
        if constexpr (NQ == 0) {
#pragma unroll
            for (int i = 0; i < 8; ++i) ssv[i] = SSQ[(size_t)(row0 + (i >> 2) * 128 + (i & 3) * 16) * LDS_ + SLOT0]; }
#pragma unroll
        for (int ai = 0; ai < 2; ++ai)
#pragma unroll
            for (int m = 0; m < 4; ++m) {
                const size_t row = (size_t)(row0 + ai * 128 + m * 16);
                float ss = 0.f;
                if constexpr (NQ == 0) ss = ssv[ai * 4 + m];
#pragma unroll
                for (int q = 0; q < NQ; ++q) { const f32x4 v = *(const f32x4*)(SSQ + row * LDS_ + SLOT0 + 4 * q); ss += (v[0] + v[1]) + (v[2] + v[3]); }
                const float rs = __builtin_amdgcn_rsqf(ss * (1.0f / KDIM) + EPS);
#pragma unroll
                for (int bj = 0; bj < 2; ++bj) *(u32x4*)(O + row * ldc + col0 + bj * 128) = pack8(acc[ai][bj][m][0] * rs, acc[ai][bj][m][1] * rs);
            }
    }
};
template <bool IN_F32, bool ATOM = false> struct ResS {
    static constexpr bool PERM = true, AFTER_DRAIN = false;
    const void* XI; bf16* XO; float* SS;
    DI void operator()(const f32x4 (&acc)[2][2][4][2], const Unit& u, int wr, int wc, int fr, int fq) const {
        const int row0 = u.pm * 256 + wr * 64 + fr, col0 = u.pn * 256 + wc * 32 + 8 * fq;
        if constexpr (IN_F32) {
#pragma unroll
            for (int ai = 0; ai < 2; ++ai) {
                f32x4 xr[4][2][2];
#pragma unroll
                for (int m = 0; m < 4; ++m)
#pragma unroll
                    for (int bj = 0; bj < 2; ++bj) { const float* p = (const float*)XI + (size_t)(row0 + ai * 128 + m * 16) * 1024 + col0 + bj * 128; xr[m][bj][0] = *(const f32x4*)p; xr[m][bj][1] = *(const f32x4*)(p + 4); }
#pragma unroll
                for (int m = 0; m < 4; ++m) { const size_t row = (size_t)(row0 + ai * 128 + m * 16), off = row * 1024 + col0; float sq = 0.f;
#pragma unroll
                    for (int bj = 0; bj < 2; ++bj) { const f32x4 v0 = xr[m][bj][0] + acc[ai][bj][m][0], v1 = xr[m][bj][1] + acc[ai][bj][m][1];
                        *(u32x4*)(XO + off + bj * 128) = pack8(v0, v1); sq += sq8(v0, v1); }
                    sq += __shfl_xor(sq, 16); sq += __shfl_xor(sq, 32);
                    if (fq == 0) { if constexpr (ATOM) unsafeAtomicAdd(SS + row, sq); else SS[row * 16 + 4 * u.pn + wc] = sq; } }
            }
        } else {
            u32x4 xw[2][4][2];
#pragma unroll
            for (int ai = 0; ai < 2; ++ai)
#pragma unroll
                for (int m = 0; m < 4; ++m)
#pragma unroll
                    for (int bj = 0; bj < 2; ++bj) xw[ai][m][bj] = *(const u32x4*)((const bf16*)XI + (size_t)(row0 + ai * 128 + m * 16) * 1024 + col0 + bj * 128);
#pragma unroll
            for (int ai = 0; ai < 2; ++ai)
#pragma unroll
                for (int m = 0; m < 4; ++m) { const size_t row = (size_t)(row0 + ai * 128 + m * 16), off = row * 1024 + col0; float sq = 0.f;
#pragma unroll
                    for (int bj = 0; bj < 2; ++bj) { const u32x4 w = xw[ai][m][bj];
                        const f32x4 x0 = (f32x4){__uint_as_float(w[0] << 16), __uint_as_float(w[0] & 0xffff0000u), __uint_as_float(w[1] << 16), __uint_as_float(w[1] & 0xffff0000u)};
                        const f32x4 x1 = (f32x4){__uint_as_float(w[2] << 16), __uint_as_float(w[2] & 0xffff0000u), __uint_as_float(w[3] << 16), __uint_as_float(w[3] & 0xffff0000u)};
                        const f32x4 v0 = x0 + acc[ai][bj][m][0], v1 = x1 + acc[ai][bj][m][1];
                        *(u32x4*)(XO + off + bj * 128) = pack8(v0, v1); sq += sq8(v0, v1); }
                    sq += __shfl_xor(sq, 16); sq += __shfl_xor(sq, 32);
                    if (fq == 0) { if constexpr (ATOM) unsafeAtomicAdd(SS + row, sq); else SS[row * 16 + 4 * u.pn + wc] = sq; } }
        }
    }
};
struct ResFinal {
    static constexpr bool PERM = true, AFTER_DRAIN = false;
    const bf16* XI; float* OUT; float* SS; unsigned* cnt; const float* gain;
    DI void operator()(const f32x4 (&acc_)[2][2][4][2], const Unit& u, int wr, int wc, int fr, int fq) const {
        f32x4 (&acc)[2][2][4][2] = const_cast<f32x4 (&)[2][2][4][2]>(acc_);
        const int row0 = u.pm * 256 + wr * 64 + fr, col0 = u.pn * 256 + wc * 32 + 8 * fq;
        u32x4 xw[2][4][2];
#pragma unroll
        for (int ai = 0; ai < 2; ++ai)
#pragma unroll
            for (int m = 0; m < 4; ++m)
#pragma unroll
                for (int bj = 0; bj < 2; ++bj) xw[ai][m][bj] = *(const u32x4*)(XI + (size_t)(row0 + ai * 128 + m * 16) * 1024 + col0 + bj * 128);
#pragma unroll
        for (int ai = 0; ai < 2; ++ai)
#pragma unroll
            for (int m = 0; m < 4; ++m) { const size_t row = (size_t)(row0 + ai * 128 + m * 16); float sq = 0.f;
#pragma unroll
                for (int bj = 0; bj < 2; ++bj) { const u32x4 w = xw[ai][m][bj];
                    const f32x4 x0 = (f32x4){__uint_as_float(w[0] << 16), __uint_as_float(w[0] & 0xffff0000u), __uint_as_float(w[1] << 16), __uint_as_float(w[1] & 0xffff0000u)};
                    const f32x4 x1 = (f32x4){__uint_as_float(w[2] << 16), __uint_as_float(w[2] & 0xffff0000u), __uint_as_float(w[3] << 16), __uint_as_float(w[3] & 0xffff0000u)};
                    acc[ai][bj][m][0] += x0; acc[ai][bj][m][1] += x1; sq += sq8(acc[ai][bj][m][0], acc[ai][bj][m][1]); }
                sq += __shfl_xor(sq, 16); sq += __shfl_xor(sq, 32);
                if (fq == 0) unsafeAtomicAdd(SS + row, sq); }
        asm volatile("s_waitcnt vmcnt(0)" ::: "memory");
        unsigned* c = cnt + 64 * u.pm;
        if (fr == 0 && fq == 0) (void)__hip_atomic_fetch_add(c, 1u, __ATOMIC_RELAXED, __HIP_MEMORY_SCOPE_AGENT);
        { unsigned sp = 0; while (__hip_atomic_load(c, __ATOMIC_RELAXED, __HIP_MEMORY_SCOPE_AGENT) < 32u) { __builtin_amdgcn_s_sleep(2); if (++sp > (1u << 22)) break; } }
        const f32x4 g00 = *(const f32x4*)(gain + col0), g01 = *(const f32x4*)(gain + col0 + 4), g10 = *(const f32x4*)(gain + col0 + 128), g11 = *(const f32x4*)(gain + col0 + 132);
        float ssv[8];
#pragma unroll
        for (int i = 0; i < 8; ++i) ssv[i] = __hip_atomic_load(SS + (size_t)(row0 + (i >> 2) * 128 + (i & 3) * 16), __ATOMIC_RELAXED, __HIP_MEMORY_SCOPE_AGENT);
#pragma unroll
        for (int ai = 0; ai < 2; ++ai)
#pragma unroll
            for (int m = 0; m < 4; ++m) { const size_t row = (size_t)(row0 + ai * 128 + m * 16), off = row * 1024 + col0;
                const float rs = __builtin_amdgcn_rsqf(ssv[ai * 4 + m] * (1.0f / 1024.0f) + EPS);
                *(f32x4*)(OUT + off) = acc[ai][0][m][0] * rs * g00; *(f32x4*)(OUT + off + 4) = acc[ai][0][m][1] * rs * g01;
                *(f32x4*)(OUT + off + 128) = acc[ai][1][m][0] * rs * g10; *(f32x4*)(OUT + off + 132) = acc[ai][1][m][1] * rs * g11; }
    }
};
struct SwiGLU {
    static constexpr bool PERM = true, AFTER_DRAIN = false;
    bf16* GU; const float* SS;
    DI void operator()(const f32x4 (&acc)[2][2][4][2], const Unit& u, int wr, int wc, int fr, int fq) const {
        const int row0 = u.pm * 256 + wr * 64 + fr, col0 = u.pn * 128 + wc * 32 + 8 * fq;
        float ssv[8];
#pragma unroll
        for (int i = 0; i < 8; ++i) ssv[i] = SS[(size_t)(row0 + (i >> 2) * 128 + (i & 3) * 16)];
#pragma unroll
        for (int ai = 0; ai < 2; ++ai)
#pragma unroll
            for (int m = 0; m < 4; ++m) {
                const size_t row = (size_t)(row0 + ai * 128 + m * 16);
                const float rs = __builtin_amdgcn_rsqf(ssv[ai * 4 + m] * (1.0f / 1024.0f) + EPS);
                const float c1 = -rs * 1.4426950408889634f, rs2 = rs * rs;
                f32x4 o[2];
#pragma unroll
                for (int n = 0; n < 2; ++n)
#pragma unroll
                    for (int j = 0; j < 4; ++j) { const float ga = acc[ai][0][m][n][j], ua = acc[ai][1][m][n][j];
                        o[n][j] = (ga * ua) * (rs2 * __builtin_amdgcn_rcpf(1.0f + __builtin_amdgcn_exp2f(ga * c1))); }
                __builtin_nontemporal_store(pack8(o[0], o[1]), (u32x4*)(GU + row * DFF + col0));
            }
    }
};
}

namespace att {
constexpr int NW = 8, QBLK = 32, KVBLK = 64;
constexpr float THR = 8.f;
constexpr int SHM_V = KVBLK * 128 * 2, SHM_K = KVBLK * 128 * 2, SHM_P = KVBLK * 64 * 2;
constexpr int OFF_V = 0, OFF_K = 2 * SHM_V, OFF_P = OFF_K + 2 * SHM_K, OFF_WS = OFF_P + 2 * SHM_P, OFF_QP = OFF_WS + NW * 64 * 4, LDS_BYTES = OFF_QP + NW * 4096;
#define KSWZ(row, colB) ((row) * 256 + ((colB) ^ (((row) & 7) << 4)))
#define PSWZ(row, colB) ((row) * 128 + ((colB) ^ ((((row) >> 1) & 7) << 4)))
#define SBAR() __builtin_amdgcn_sched_barrier(0)
DI int crow(int r, int hi) { return (r & 3) + 8 * (r >> 2) + 4 * hi; }
DI unsigned cvtpk(float lo, float hi) { unsigned r; asm volatile("v_cvt_pk_bf16_f32 %0, %1, %2" : "=v"(r) : "v"(lo), "v"(hi)); return r; }
DI unsigned short f2bf(float f) { unsigned u = __builtin_bit_cast(unsigned, f); return (unsigned short)((u + 0x7fffu + ((u >> 16) & 1u)) >> 16); }

template <int SC1000000>
struct Sc { static constexpr float SCALE = SC1000000 * 1e-6f; };

DI void partialSM(f32x16& p0, f32x16& p1, float& m_reg, float& mn, float& alpha, const float SCALE) {
  const float C = SCALE * 1.4426950408889634f;
  float pmax = p0[0];
#pragma unroll
  for (int r = 1; r < 16; ++r) pmax = fmaxf(pmax, p0[r]);
#pragma unroll
  for (int r = 0; r < 16; ++r) pmax = fmaxf(pmax, p1[r]);
  { auto rr = __builtin_amdgcn_permlane32_swap(__float_as_uint(pmax), __float_as_uint(pmax), false, false);
    pmax = fmaxf(__uint_as_float(rr[0]), __uint_as_float(rr[1])); }
  if (__builtin_expect(__all(pmax - m_reg <= THR / SCALE), 1)) { mn = m_reg; alpha = 1.f; }
  else { mn = fmaxf(m_reg, pmax); alpha = __builtin_amdgcn_exp2f((m_reg - mn) * C); m_reg = mn; }
  float mnC = -mn * C;
#pragma unroll
  for (int r = 0; r < 16; ++r) p0[r] = fmaf(p0[r], C, mnC);
#pragma unroll
  for (int r = 0; r < 16; ++r) p1[r] = fmaf(p1[r], C, mnC);
#pragma unroll
  for (int r = 0; r < 16; ++r) p0[r] = __builtin_amdgcn_exp2f(p0[r]);
}
#define PK4(P, BASE, OUT) do { unsigned a0 = cvtpk(P[BASE + 0], P[BASE + 1]), a1 = cvtpk(P[BASE + 2], P[BASE + 3]);   \
    unsigned b0 = cvtpk(P[BASE + 4], P[BASE + 5]), b1 = cvtpk(P[BASE + 6], P[BASE + 7]);                              \
    auto r0 = __builtin_amdgcn_permlane32_swap(a0, b0, false, false); auto r1 = __builtin_amdgcn_permlane32_swap(a1, b1, false, false); \
    u32x4 w = {r0[0], r1[0], r0[1], r1[1]}; OUT = *reinterpret_cast<bf16x8*>(&w); } while (0)
DI void finishSM(f32x16& p0, f32x16& p1, float alpha, float& l_reg, bf16x8& pa0, bf16x8& pa1, bf16x8& pa2, bf16x8& pa3) {
#pragma unroll
  for (int r = 0; r < 16; ++r) p1[r] = __builtin_amdgcn_exp2f(p1[r]);
  float ps = 0;
#pragma unroll
  for (int r = 0; r < 16; ++r) ps += p0[r];
#pragma unroll
  for (int r = 0; r < 16; ++r) ps += p1[r];
  { auto rr = __builtin_amdgcn_permlane32_swap(__float_as_uint(ps), __float_as_uint(ps), false, false);
    ps = __uint_as_float(rr[0]) + __uint_as_float(rr[1]); }
  l_reg = l_reg * alpha + ps;
  PK4(p0, 0, pa0); PK4(p0, 8, pa1); PK4(p1, 0, pa2); PK4(p1, 8, pa3);
}
template <int NPE>
DI void qkt(f32x16& p0, f32x16& p1, const char* Ks, const char* Ps, const bf16x8* qr, const char* Qp, int r32, int hi) {
  p0 = f32x16{}; p1 = f32x16{};
#pragma unroll
  for (int d0 = 0; d0 < 8; ++d0) { int cb = (d0 * 16 + hi * 8) * 2;
    bf16x8 b0 = *reinterpret_cast<const bf16x8*>(Ks + KSWZ(r32, cb));
    bf16x8 b1 = *reinterpret_cast<const bf16x8*>(Ks + KSWZ(32 + r32, cb));
    p0 = __builtin_amdgcn_mfma_f32_32x32x16_bf16(b0, qr[d0], p0, 0, 0, 0);
    p1 = __builtin_amdgcn_mfma_f32_32x32x16_bf16(b1, qr[d0], p1, 0, 0, 0); }
#pragma unroll
  for (int d0 = 0; d0 < NPE; ++d0) { int cb = (d0 * 16 + hi * 8) * 2;
    bf16x8 b0 = *reinterpret_cast<const bf16x8*>(Ps + PSWZ(r32, cb));
    bf16x8 b1 = *reinterpret_cast<const bf16x8*>(Ps + PSWZ(32 + r32, cb));
    const bf16x8 qq = *reinterpret_cast<const bf16x8*>(Qp + PSWZ(r32, cb));
    p0 = __builtin_amdgcn_mfma_f32_32x32x16_bf16(b0, qq, p0, 0, 0, 0);
    p1 = __builtin_amdgcn_mfma_f32_32x32x16_bf16(b1, qq, p1, 0, 0, 0); }
}
DI int v_st(int k, int c) { const int kk = (k & ~0xC) | ((k & 4) << 1) | ((k & 8) >> 1); return ((kk >> 3) * 4 + (c >> 5)) * 512 + ((kk & 7) * 32 + (c & 31)) * 2; }
DI int v_rd_base(int lane) { return ((lane & 3) << 3) | (((lane >> 2) & 3) << 6) | (((lane >> 4) & 1) << 5) | (((lane >> 5) & 1) << 8); }
constexpr int v_rd_off(int d0, int ks, int half) { return d0 * 512 + ks * 4096 + half * 2048; }
template <int OFF> DI s16x4 tr_read(int vb) {
  s16x4 r; asm volatile("ds_read_b64_tr_b16 %0, %1 offset:%2" : "=&v"(r) : "v"(vb), "i"(OFF) : "memory"); return r;
}
template <int D0, bool SPLIT> DI void pv_one(f32x16& od, int vb, bf16x8 pa0, bf16x8 pa1, bf16x8 pa2, bf16x8 pa3) {
#define PKV(L, H) (bf16x8){L[0], L[1], L[2], L[3], H[0], H[1], H[2], H[3]}
  if constexpr (SPLIT) {
    { const s16x4 l0 = tr_read<v_rd_off(D0, 0, 0)>(vb), h0 = tr_read<v_rd_off(D0, 0, 1)>(vb), l1 = tr_read<v_rd_off(D0, 1, 0)>(vb), h1 = tr_read<v_rd_off(D0, 1, 1)>(vb);
      asm volatile("s_waitcnt lgkmcnt(0)" ::: "memory"); SBAR();
      od = __builtin_amdgcn_mfma_f32_32x32x16_bf16(PKV(l0, h0), pa0, od, 0, 0, 0);
      od = __builtin_amdgcn_mfma_f32_32x32x16_bf16(PKV(l1, h1), pa1, od, 0, 0, 0); }
    SBAR();
    { const s16x4 l2 = tr_read<v_rd_off(D0, 2, 0)>(vb), h2 = tr_read<v_rd_off(D0, 2, 1)>(vb), l3 = tr_read<v_rd_off(D0, 3, 0)>(vb), h3 = tr_read<v_rd_off(D0, 3, 1)>(vb);
      asm volatile("s_waitcnt lgkmcnt(0)" ::: "memory"); SBAR();
      od = __builtin_amdgcn_mfma_f32_32x32x16_bf16(PKV(l2, h2), pa2, od, 0, 0, 0);
      od = __builtin_amdgcn_mfma_f32_32x32x16_bf16(PKV(l3, h3), pa3, od, 0, 0, 0); }
    SBAR();
  } else {
  const s16x4 l0 = tr_read<v_rd_off(D0, 0, 0)>(vb), h0 = tr_read<v_rd_off(D0, 0, 1)>(vb), l1 = tr_read<v_rd_off(D0, 1, 0)>(vb), h1 = tr_read<v_rd_off(D0, 1, 1)>(vb);
  const s16x4 l2 = tr_read<v_rd_off(D0, 2, 0)>(vb), h2 = tr_read<v_rd_off(D0, 2, 1)>(vb), l3 = tr_read<v_rd_off(D0, 3, 0)>(vb), h3 = tr_read<v_rd_off(D0, 3, 1)>(vb);
  asm volatile("s_waitcnt lgkmcnt(0)" ::: "memory"); SBAR();
  od = __builtin_amdgcn_mfma_f32_32x32x16_bf16(PKV(l0, h0), pa0, od, 0, 0, 0);
  od = __builtin_amdgcn_mfma_f32_32x32x16_bf16(PKV(l1, h1), pa1, od, 0, 0, 0);
  od = __builtin_amdgcn_mfma_f32_32x32x16_bf16(PKV(l2, h2), pa2, od, 0, 0, 0);
  od = __builtin_amdgcn_mfma_f32_32x32x16_bf16(PKV(l3, h3), pa3, od, 0, 0, 0);
  }
}
template <bool SPLIT>
DI void pv_d0(f32x16* o, int vb, bf16x8 pa0, bf16x8 pa1, bf16x8 pa2, bf16x8 pa3) {
  pv_one<0, SPLIT>(o[0], vb, pa0, pa1, pa2, pa3); pv_one<1, SPLIT>(o[1], vb, pa0, pa1, pa2, pa3); pv_one<2, SPLIT>(o[2], vb, pa0, pa1, pa2, pa3); pv_one<3, SPLIT>(o[3], vb, pa0, pa1, pa2, pa3);
}
constexpr int R_STG = 40960, R_V = 0, R_K = 16384, R_P = 32768, R_WS = 3 * R_STG, RING_LDS_BYTES = R_WS + NW * 64 * 4;
template <int NPE>
DI void qkt_r(f32x16& p0, f32x16& p1, const char* Ks, const char* Ps, const bf16x8* qr, int r32, int hi) {
  p0 = f32x16{}; p1 = f32x16{};
#pragma unroll
  for (int d0 = 0; d0 < 8; ++d0) { int cb = (d0 * 16 + hi * 8) * 2;
    bf16x8 b0 = *reinterpret_cast<const bf16x8*>(Ks + KSWZ(r32, cb));
    bf16x8 b1 = *reinterpret_cast<const bf16x8*>(Ks + KSWZ(32 + r32, cb));
    p0 = __builtin_amdgcn_mfma_f32_32x32x16_bf16(b0, qr[d0], p0, 0, 0, 0);
    p1 = __builtin_amdgcn_mfma_f32_32x32x16_bf16(b1, qr[d0], p1, 0, 0, 0); }
#pragma unroll
  for (int d0 = 0; d0 < NPE; ++d0) { int cb = (d0 * 16 + hi * 8) * 2;
    bf16x8 b0 = *reinterpret_cast<const bf16x8*>(Ps + PSWZ(r32, cb));
    bf16x8 b1 = *reinterpret_cast<const bf16x8*>(Ps + PSWZ(32 + r32, cb));
    p0 = __builtin_amdgcn_mfma_f32_32x32x16_bf16(b0, qr[8 + d0], p0, 0, 0, 0);
    p1 = __builtin_amdgcn_mfma_f32_32x32x16_bf16(b1, qr[8 + d0], p1, 0, 0, 0); }
}
template <int NPE, int LDQ, int LDK, int VOFF, int LDO>
DI void dense_ring(const bf16* __restrict__ Qb, const bf16* __restrict__ Kh, const bf16* __restrict__ Ph, const float* __restrict__ TCq, const float* __restrict__ TSq,
                   bf16* __restrict__ Ob, int seq, const float SCALE, char* lds) {
  const int tid = opaque_tid(), wid = tid >> 6, lane = tid & 63, r32 = lane & 31, hi = lane >> 5;
  unsigned vof[2], kof[2], pof;
#pragma unroll
  for (int j = 0; j < 2; ++j) { const int sp = 2 * wid + j;
    { const int st = 2 * sp + (lane >> 5), kk = (st >> 2) * 8 + ((lane & 31) >> 2), k = (kk & ~0xC) | ((kk & 4) << 1) | ((kk & 8) >> 1), c = (st & 3) * 32 + (lane & 3) * 8;
      vof[j] = (unsigned)(k * LDK + VOFF + c) * 2u; }
    { const int row = 4 * sp + (lane >> 4), ch = (lane & 15) ^ (row & 7); kof[j] = (unsigned)(row * LDK + ch * 8) * 2u; } }
  { const int row = 8 * wid + (lane >> 3), ch = (lane & 7) ^ ((row >> 1) & 7); pof = (unsigned)(row * 64 + ch * 8) * 2u; }
#define ISSUE(k0, stg) do { const char* kb_ = (const char*)(Kh + (size_t)(k0) * LDK); char* sg_ = (stg); \
    _Pragma("unroll") for (int j_ = 0; j_ < 2; ++j_) { \
      __builtin_amdgcn_global_load_lds((const unsigned*)(kb_ + vof[j_]), (LAS unsigned*)(uintptr_t)(sg_ + R_V + (2 * wid + j_) * 1024), 16, 0, 0); \
      __builtin_amdgcn_global_load_lds((const unsigned*)(kb_ + kof[j_]), (LAS unsigned*)(uintptr_t)(sg_ + R_K + (2 * wid + j_) * 1024), 16, 0, 0); } \
    if constexpr (NPE > 0) __builtin_amdgcn_global_load_lds((const unsigned*)((const char*)(Ph + (size_t)(k0) * 64) + pof), (LAS unsigned*)(uintptr_t)(sg_ + R_P + wid * 1024), 16, 0, 0); } while (0)
#define RBAR() do { asm volatile("s_waitcnt vmcnt(0) lgkmcnt(0)" ::: "memory"); __builtin_amdgcn_s_barrier(); asm volatile("" ::: "memory"); } while (0)
  char* s_prev = lds; char* s_cur = lds + R_STG; char* s_next = lds + 2 * R_STG;
  ISSUE(0, s_prev); ISSUE(KVBLK, s_cur);
  float m_reg = -1e30f, l_reg = 0; f32x16 o[4] = {}; bf16x8 qr[8 + NPE];
  const bf16* Qw = (const bf16*)((const char*)Qb + (unsigned)((wid * QBLK + r32) * LDQ + hi * 8) * 2u);
#pragma unroll
  for (int d0 = 0; d0 < 8; ++d0) qr[d0] = *reinterpret_cast<const bf16x8*>(Qw + d0 * 16);
  if constexpr (NPE > 0) {
    const unsigned tqo = (unsigned)((wid * QBLK + r32) * 32 + hi * 8) * 4u;
#pragma unroll
    for (int d0 = 0; d0 < 2; ++d0) {
      const u32x4 x1 = *reinterpret_cast<const u32x4*>(Qw + 128 + d0 * 16), x2 = *reinterpret_cast<const u32x4*>(Qw + 160 + d0 * 16);
      const f32x4 cA = *(const f32x4*)((const char*)TCq + tqo + d0 * 64), cB = *(const f32x4*)((const char*)TCq + tqo + d0 * 64 + 16);
      const f32x4 sA = *(const f32x4*)((const char*)TSq + tqo + d0 * 64), sB = *(const f32x4*)((const char*)TSq + tqo + d0 * 64 + 16);
      u32x4 y1, y2;
#pragma unroll
      for (int e = 0; e < 4; ++e) {
        const float a0 = __uint_as_float(x1[e] << 16), a1 = __uint_as_float(x1[e] & 0xffff0000u), b0 = __uint_as_float(x2[e] << 16), b1 = __uint_as_float(x2[e] & 0xffff0000u);
        const float c0 = (e < 2) ? cA[2 * e] : cB[2 * e - 4], c1 = (e < 2) ? cA[2 * e + 1] : cB[2 * e - 3], s0 = (e < 2) ? sA[2 * e] : sB[2 * e - 4], s1 = (e < 2) ? sA[2 * e + 1] : sB[2 * e - 3];
        y1[e] = cvtpk(a0 * c0 - b0 * s0, a1 * c1 - b1 * s1); y2[e] = cvtpk(b0 * c0 + a0 * s0, b1 * c1 + a1 * s1); }
      qr[8 + d0] = *reinterpret_cast<bf16x8*>(&y1); qr[8 + d0 + 2] = *reinterpret_cast<bf16x8*>(&y2);
    }
  }
#define RESC(a) do { if (__any((a) < 1.f)) { _Pragma("unroll") for (int d = 0; d < 4; ++d) o[d] *= (a); } } while (0)
  f32x16 pA0, pA1, pB0, pB1; float mnA, mnB, alA, alB; bf16x8 pa0, pa1, pa2, pa3; const int NT = seq / KVBLK;
  const int vlane = v_rd_base(lane);
  RBAR();
  ISSUE(2 * KVBLK, s_next);
  qkt_r<NPE>(pA0, pA1, s_prev + R_K, s_prev + R_P, qr, r32, hi); partialSM(pA0, pA1, m_reg, mnA, alA, SCALE);
#define RTILE(PC0, PC1, PP0, PP1, mnC, alC, alP, jt) do { \
    SBAR(); qkt_r<NPE>(PC0, PC1, s_cur + R_K, s_cur + R_P, qr, r32, hi); \
    finishSM(PP0, PP1, alP, l_reg, pa0, pa1, pa2, pa3); SBAR(); \
    pv_d0<false>(o, (int)(uintptr_t)(s_prev + R_V) + vlane, pa0, pa1, pa2, pa3); partialSM(PC0, PC1, m_reg, mnC, alC, SCALE); \
    RESC(alC); \
    RBAR(); \
    if ((jt) + 2 < NT) ISSUE(((jt) + 2) * KVBLK, s_prev); \
    { char* t_ = s_prev; s_prev = s_cur; s_cur = s_next; s_next = t_; } } while (0)
  for (int j = 1; j + 1 < NT; j += 2) {
    RTILE(pB0, pB1, pA0, pA1, mnB, alB, alA, j);
    RTILE(pA0, pA1, pB0, pB1, mnA, alA, alB, j + 1);
  }
  RTILE(pB0, pB1, pA0, pA1, mnB, alB, alA, NT - 1);
  finishSM(pB0, pB1, alB, l_reg, pa0, pa1, pa2, pa3); SBAR();
  pv_d0<false>(o, (int)(uintptr_t)(s_prev + R_V) + vlane, pa0, pa1, pa2, pa3);
  { const float rl = __builtin_amdgcn_rcpf(l_reg);
    bf16* Ow = Ob + (long)(wid * QBLK + r32) * LDO + 8 * hi;
#pragma unroll
    for (int d0 = 0; d0 < 4; ++d0) { o[d0] *= rl; bf16x8 w0, w1; PK4(o[d0], 0, w0); PK4(o[d0], 8, w1);
      *(bf16x8*)(Ow + d0 * 32) = w0; *(bf16x8*)(Ow + d0 * 32 + 16) = w1; } }
  RBAR();
#undef ISSUE
#undef RBAR
#undef RESC
#undef RTILE
}
}

namespace dil {
using att::crow; using att::cvtpk; using att::f2bf;
constexpr int OFF_K = 0, OFF_V = 49152, OFF_POS = 98304, OFF_WS = OFF_POS + 2048, LDS_BYTES = OFF_WS + 8 * 64 * 4;
typedef short v4i16_t __attribute__((ext_vector_type(4)));
DI int v_st64(int k, int c) { const int kk = (k & ~0xC) | ((k & 4) << 1) | ((k & 8) >> 1); return ((kk >> 3) * 2 + (c >> 5)) * 512 + ((kk & 7) * 32 + (c & 31)) * 2; }
DI s16x4 vtr(const char* p) { return __builtin_bit_cast(s16x4, __builtin_amdgcn_ds_read_tr16_b64_v4i16((LAS v4i16_t*)(uintptr_t)p)); }

DI void unit(const bf16* __restrict__ QKV, const int* __restrict__ pos, bf16* __restrict__ OA, float* __restrict__ LSE,
             int b, int h, int d, int r, int qb, float slope, char* lds) {
  const int tid = opaque_tid(), wid = tid >> 6, lane = tid & 63, r32 = lane & 31, hi = lane >> 5;
  const int L = SEQ / d, u0 = qb * 256;
  char* K_lds = lds + OFF_K; char* V_lds = lds + OFF_V; int* posk = (int*)(lds + OFF_POS); float* ws = (float*)(lds + OFF_WS) + wid * 64;
  const bf16* base = QKV + (size_t)(b * 8 + h) * SEQ * 64;
  constexpr size_t PLANE = (size_t)NB * 8 * SEQ * 64 * 2;
  auto stage = [&](const int i0) {
    bf16x8 kreg[3], vreg[3];
#pragma unroll
    for (int i = 0; i < 3; ++i) { const int idx = tid + (i0 + i) * 512, row = idx >> 3, ch = idx & 7, v = u0 - 64 + row; const bool ok = (v >= 0) && (v < L);
      const unsigned go = (unsigned)((r + d * (ok ? v : 0)) * 64 + ch * 8) * 2u;
      kreg[i] = *(const bf16x8*)((const char*)base + PLANE + go); vreg[i] = *(const bf16x8*)((const char*)base + 2 * PLANE + go);
      if (!ok) { kreg[i] = bf16x8{}; vreg[i] = bf16x8{}; } }
#pragma unroll
    for (int i = 0; i < 3; ++i) { const int idx = tid + (i0 + i) * 512, row = idx >> 3, ch = idx & 7;
      *(bf16x8*)(K_lds + PSWZ(row, ch * 16)) = kreg[i]; *(bf16x8*)(V_lds + v_st64(row, ch * 8)) = vreg[i]; }
  };
  stage(0); SBAR(); stage(3); SBAR();
  float pkv = 3.0e8f; if (tid < 384) { const int v = u0 - 64 + tid; if (v >= 0 && v < L) pkv = (float)pos[b * SEQ + r + d * v]; }
  const int uq = u0 + wid * 32 + r32, tq = r + d * uq;
  bf16x8 qr[4];
#pragma unroll
  for (int d0 = 0; d0 < 4; ++d0) qr[d0] = *(const bf16x8*)((const char*)base + (unsigned)(tq * 64 + d0 * 16 + hi * 8) * 2u);
  const int pq = pos[b * SEQ + tq];
  if (tid < 384) ((float*)posk)[tid] = pkv;
  __syncthreads();
  f32x16 p[5];
#pragma unroll
  for (int ta = 0; ta < 5; ++ta) { p[ta] = f32x16{};
#pragma unroll
    for (int d0 = 0; d0 < 4; ++d0) { const bf16x8 a = *(const bf16x8*)(K_lds + PSWZ(wid * 32 + ta * 32 + r32, (d0 * 16 + hi * 8) * 2));
      p[ta] = __builtin_amdgcn_mfma_f32_32x32x16_bf16(a, qr[d0], p[ta], 0, 0, 0); }
    SBAR(); }
  const float C = 0.125f * 1.4426950408889634f, sl2 = slope * 1.4426950408889634f;
  const float* pbase = (const float*)posk + wid * 32 + 4 * hi; const float pqf = (float)pq;
  float mx = -1e30f;
#pragma unroll
  for (int ta = 0; ta < 5; ++ta) {
#pragma unroll
    for (int g = 0; g < 4; ++g) { const f32x4 pk4 = *(const f32x4*)(pbase + ta * 32 + 8 * g);
#pragma unroll
      for (int j = 0; j < 4; ++j) { const int rr = 4 * g + j, kr = j + 8 * g + 4 * hi;
        float sc = fmaf(__builtin_fabsf(pqf - pk4[j]), -sl2, p[ta][rr] * C);
        if (ta == 0) sc = (kr >= r32) ? sc : -1e30f;
        if (ta == 4) sc = (kr <= r32) ? sc : -1e30f;
        p[ta][rr] = sc; mx = fmaxf(mx, sc); } }
    SBAR(); }
  { auto x = __builtin_amdgcn_permlane32_swap(__float_as_uint(mx), __float_as_uint(mx), false, false); mx = fmaxf(__uint_as_float(x[0]), __uint_as_float(x[1])); }
  float ls = 0.f;
#pragma unroll
  for (int ta = 0; ta < 5; ++ta)
#pragma unroll
    for (int rr = 0; rr < 16; ++rr) { p[ta][rr] = __builtin_amdgcn_exp2f(p[ta][rr] - mx); ls += p[ta][rr]; if (rr == 15) SBAR(); }
  { auto x = __builtin_amdgcn_permlane32_swap(__float_as_uint(ls), __float_as_uint(ls), false, false); ls = __uint_as_float(x[0]) + __uint_as_float(x[1]); }
  f32x16 o[2] = {};
  const char* vb = V_lds + att::v_rd_base(lane) + wid * 2 * 2048;
#pragma unroll
  for (int ta = 0; ta < 5; ++ta) {
    bf16x8 pa0, pa1; PK4(p[ta], 0, pa0); PK4(p[ta], 8, pa1);
#pragma unroll
    for (int d0 = 0; d0 < 2; ++d0) {
      const s16x4 l0 = vtr(vb + (2 * ta) * 2048 + d0 * 512), h0 = vtr(vb + (2 * ta) * 2048 + 1024 + d0 * 512);
      const s16x4 l1 = vtr(vb + (2 * ta + 1) * 2048 + d0 * 512), h1 = vtr(vb + (2 * ta + 1) * 2048 + 1024 + d0 * 512);
      o[d0] = __builtin_amdgcn_mfma_f32_32x32x16_bf16((bf16x8){l0[0], l0[1], l0[2], l0[3], h0[0], h0[1], h0[2], h0[3]}, pa0, o[d0], 0, 0, 0);
      o[d0] = __builtin_amdgcn_mfma_f32_32x32x16_bf16((bf16x8){l1[0], l1[1], l1[2], l1[3], h1[0], h1[1], h1[2], h1[3]}, pa1, o[d0], 0, 0, 0);
    }
    SBAR();
  }
  if (hi == 0) LSE[(size_t)(b * SEQ + tq) * 8 + h] = (mx + __builtin_amdgcn_logf(ls)) * 0.6931471805599453f;
  { const float rl = __builtin_amdgcn_rcpf(ls); bf16* orow = OA + (size_t)(b * SEQ + tq) * 512 + h * 64 + 8 * hi;
#pragma unroll
    for (int d0 = 0; d0 < 2; ++d0) { o[d0] *= rl; bf16x8 w0, w1; PK4(o[d0], 0, w0); PK4(o[d0], 8, w1);
      *(bf16x8*)(orow + d0 * 32) = w0; *(bf16x8*)(orow + d0 * 32 + 16) = w1; } }
  __syncthreads();
}
}

#define XB_TMO      128
#define XB_XCNT(j)  (256  + 64 * (j))
#define XB_XSUB(j)  (1280 + 64 * (j))
#define XB_XGEN(j)  (2304 + 64 * (j))
#define XB_TOP      3328
#define XB_TOPGEN   3392
#define XCD_BAR_WORDS 3456
#define XB_SPIN_CAP (1u << 18)

__device__ __forceinline__ unsigned xb_ld(unsigned* p)              { return __hip_atomic_load(p, __ATOMIC_RELAXED, __HIP_MEMORY_SCOPE_AGENT); }
__device__ __forceinline__ unsigned xb_add(unsigned* p, unsigned v) { return __hip_atomic_fetch_add(p, v, __ATOMIC_RELAXED, __HIP_MEMORY_SCOPE_AGENT); }
__device__ __forceinline__ unsigned xb_xcc_id() { return (unsigned)__builtin_amdgcn_s_getreg((3 << 11) | 20) & 0xFu; }
#define XB_SPIN(cond, bar) do { unsigned _sp = 0; while (cond) { __builtin_amdgcn_s_sleep(1); \
    if ((++_sp & 255u) == 0u) { if (xb_ld(&(bar)[XB_TMO])) break; if (_sp > XB_SPIN_CAP) { atomicAdd(&(bar)[XB_TMO], 1u); break; } } } } while (0)

struct XcdBarrier {
    unsigned* bar; unsigned x;
    volatile LAS unsigned* st;
};

__device__ __forceinline__ XcdBarrier xcd_barrier_post(unsigned* bar, volatile LAS unsigned* st) {
    XcdBarrier b; b.bar = bar; b.x = xb_xcc_id(); b.st = st;
    if (threadIdx.x == 0) (void)xb_add(&bar[XB_XCNT(b.x)], 1u);
    return b;
}
__device__ __forceinline__ void xcd_barrier_complete(unsigned* bar, unsigned x, unsigned& nloc, unsigned& nx) {
    const unsigned G = gridDim.x * gridDim.y * gridDim.z;
    unsigned sum, cnt, mine, sp = 0u;
    for (;;) {
        sum = 0u; cnt = 0u; mine = 0u;
#pragma unroll
        for (unsigned j = 0; j < 16; ++j) { const unsigned c = xb_ld(&bar[XB_XCNT(j)]); sum += c; cnt += (c > 0u) ? 1u : 0u; mine = (j == x) ? c : mine; }
        if (sum == G) break;
        __builtin_amdgcn_s_sleep(1);
        if ((++sp & 255u) == 0u) { if (xb_ld(&bar[XB_TMO])) break; if (sp > XB_SPIN_CAP) { atomicAdd(&bar[XB_TMO], 1u); break; } }
    }
    nloc = mine > 0u ? mine : 1u; nx = cnt > 0u ? cnt : 1u;
}

__device__ __forceinline__ void xcd_barrier(const XcdBarrier& b) {
    asm volatile("s_waitcnt vmcnt(0)" ::: "memory");
    __syncthreads();
    if (threadIdx.x == 0) {
        unsigned* bar = b.bar;
        __builtin_amdgcn_s_waitcnt(0);
        unsigned nloc = b.st[0], nx = b.st[1];
        if (nloc == 0u) { xcd_barrier_complete(bar, b.x, nloc, nx); b.st[0] = nloc; b.st[1] = nx; }
        const unsigned old = xb_add(&bar[XB_XSUB(b.x)], 1u);
        const unsigned gen = old / nloc;
        if (old + 1u == (gen + 1u) * nloc) {
            __builtin_amdgcn_fence(__ATOMIC_RELEASE, "agent");
            asm volatile("s_waitcnt vmcnt(0)" ::: "memory");
            const unsigned og = xb_add(&bar[XB_TOP], 1u);
            const unsigned tg = og / nx;
            if (og + 1u == (tg + 1u) * nx) xb_add(&bar[XB_TOPGEN], 1u);
            else XB_SPIN(xb_ld(&bar[XB_TOPGEN]) == tg, bar);
            __builtin_amdgcn_fence(__ATOMIC_ACQUIRE, "agent");
            xb_add(&bar[XB_XGEN(b.x)], 1u);
            asm volatile("s_waitcnt vmcnt(0)" ::: "memory");
        } else {
            XB_SPIN(xb_ld(&bar[XB_XGEN(b.x)]) == gen, bar);
            __builtin_amdgcn_fence(__ATOMIC_ACQUIRE, "agent");
            asm volatile("s_waitcnt vmcnt(0)" ::: "memory");
        }
    }
    __syncthreads();
}

constexpr size_t MiB = 1u << 20;
constexpr size_t WS_WIN = 0, WS_WMKV = WS_WIN + (size_t)DIN_PAD * 1024 * 2, WS_WQ = WS_WMKV + 2 * MiB, WS_WKV = WS_WQ + (size_t)768 * 384 * 2, WS_WOUT = WS_WKV + (size_t)1024 * 256 * 2,
                 WS_WMQ = WS_WOUT + 2 * MiB, WS_WMO = WS_WMQ + 1 * MiB, WS_WGU = WS_WMO + 1 * MiB, WS_WDN = WS_WGU + 11 * MiB, WS_WEND = WS_WDN + (size_t)1024 * DFF * 2;
static_assert(WS_WEND <= 32 * MiB, "weights");
constexpr size_t WS_CTL = 31 * MiB, CTL_BYTES = 16384, WS_PCNT = WS_CTL + CTL_BYTES;
static_assert(WS_WEND <= WS_CTL && XCD_BAR_WORDS * 4 <= CTL_BYTES, "ctl");
constexpr size_t WS_HB = 32 * MiB, WS_MK = 96 * MiB, WS_MKV = 100 * MiB, WS_TC = 104 * MiB, WS_TS = 108 * MiB, WS_KPE = 112 * MiB, WS_LSE = 116 * MiB, WS_SSQ = 120 * MiB,
                 WS_OB = 124 * MiB, WS_OA = 156 * MiB, WS_R = 252 * MiB;
constexpr size_t WS_QKV = WS_R, WS_KVB = WS_R + 96 * MiB, WS_QB = WS_KVB + 64 * MiB, WS_CQ = WS_QB + 48 * MiB, WS_CKV = WS_CQ + 24 * MiB, WS_SS3F = WS_CKV + 16 * MiB, WS_RS2 = WS_SS3F + 2 * MiB, WS_END = WS_RS2 + 1 * MiB;
constexpr size_t WS_MQ = WS_R, WS_MO = WS_R + 32 * MiB, WS_GU = WS_R;
constexpr size_t WS_XB1 = WS_OA, WS_XB2 = WS_HB, WS_X3 = WS_OA, WS_SS1 = WS_LSE, WS_SS2 = WS_LSE + 2 * MiB, WS_SS3 = WS_SSQ;
static_assert(WS_END <= 512 * MiB && WS_GU + (size_t)T * DFF * 2 <= WS_END, "workspace map");
constexpr int MISC_OFF = 131072 + 2048;
constexpr int LDS_BYTES = 135168;
static_assert(att::RING_LDS_BYTES <= MISC_OFF && att::LDS_BYTES <= MISC_OFF && dil::LDS_BYTES <= MISC_OFF && pg8::STAGE_BYTES <= MISC_OFF && MISC_OFF + 64 <= LDS_BYTES, "LDS");

struct Params {
    const float *x, *mem; const int* pos;
    const float *norm_mix, *w_in, *q_norm, *w_q_up, *kv_norm, *w_kv_up, *gout_a, *gout_b, *w_out, *norm_mem_q, *norm_mem_kv, *w_mq, *w_mkv, *w_mo, *norm_ffn, *w_gate, *w_up, *w_down, *norm_final;
    float* out; unsigned char* ws;
};

DI float wave_sum(float v) {
#pragma unroll
    for (int o = 1; o < 64; o <<= 1) v += __shfl_xor(v, o);
    return v;
}
DI unsigned pk2(float lo, float hi) { return pg8::cvt_pk_bf16(lo, hi); }

DI void transpose_item(const float* W, int ldn, int sc, const float* gain, bf16* WT, int K, int drow, int k0, LAS float* scr, int lane) {
    float tv[32];
#pragma unroll
    for (int i = 0; i < 32; ++i) { const int kk = 2 * i + (lane >> 5); tv[i] = 0.f;
        if (sc >= 0) { tv[i] = W[(size_t)(k0 + kk) * ldn + sc + (lane & 31)]; if (gain) tv[i] *= gain[k0 + kk]; } }
#pragma unroll
    for (int i = 0; i < 32; ++i) scr[(2 * i + (lane >> 5)) * 33 + (lane & 31)] = tv[i];
    asm volatile("s_waitcnt lgkmcnt(0)" ::: "memory");
    const int c = lane & 7;
#pragma unroll
    for (int j = 0; j < 4; ++j) { const int n = (lane >> 3) + 8 * j; const LAS float* s = scr + (8 * c) * 33 + n;
        u32x4 o; o.x = pk2(s[0 * 33], s[1 * 33]); o.y = pk2(s[2 * 33], s[3 * 33]); o.z = pk2(s[4 * 33], s[5 * 33]); o.w = pk2(s[6 * 33], s[7 * 33]);
        *(u32x4*)(WT + (size_t)(drow + n) * K + k0 + 8 * c) = o; }
    asm volatile("s_waitcnt lgkmcnt(0)" ::: "memory");
}
DI void norm_row_bf16(const float* xrow, const float* g, bf16* orow, int lane) {
    f32x4 v[4]; float s = 0.f;
#pragma unroll
    for (int j = 0; j < 4; ++j) { v[j] = *(const f32x4*)(xrow + 256 * j + 4 * lane); s += (v[j][0] * v[j][0] + v[j][1] * v[j][1]) + (v[j][2] * v[j][2] + v[j][3] * v[j][3]); }
    const float rs = __builtin_amdgcn_rsqf(wave_sum(s) * (1.f / 1024.f) + EPS);
#pragma unroll
    for (int j = 0; j < 4; ++j) { const f32x4 gg = *(const f32x4*)(g + 256 * j + 4 * lane);
        u32x2 o; o.x = pk2(v[j][0] * rs * gg[0], v[j][1] * rs * gg[1]); o.y = pk2(v[j][2] * rs * gg[2], v[j][3] * rs * gg[3]);
        *(u32x2*)(orow + 256 * j + 4 * lane) = o; }
}
DI void norm_row2_bf16(const float* xa, const float* xb, const float* g, bf16* oa, bf16* ob, int lane) {
    f32x4 va[4], vb[4]; float sa = 0.f, sb = 0.f;
#pragma unroll
    for (int j = 0; j < 4; ++j) { va[j] = *(const f32x4*)(xa + 256 * j + 4 * lane); vb[j] = *(const f32x4*)(xb + 256 * j + 4 * lane); }
#pragma unroll
    for (int j = 0; j < 4; ++j) { sa += (va[j][0] * va[j][0] + va[j][1] * va[j][1]) + (va[j][2] * va[j][2] + va[j][3] * va[j][3]); sb += (vb[j][0] * vb[j][0] + vb[j][1] * vb[j][1]) + (vb[j][2] * vb[j][2] + vb[j][3] * vb[j][3]); }
    const float ra = __builtin_amdgcn_rsqf(wave_sum(sa) * (1.f / 1024.f) + EPS), rb = __builtin_amdgcn_rsqf(wave_sum(sb) * (1.f / 1024.f) + EPS);
#pragma unroll
    for (int j = 0; j < 4; ++j) { const f32x4 gg = *(const f32x4*)(g + 256 * j + 4 * lane);
        u32x2 o; o.x = pk2(va[j][0] * ra * gg[0], va[j][1] * ra * gg[1]); o.y = pk2(va[j][2] * ra * gg[2], va[j][3] * ra * gg[3]); *(u32x2*)(oa + 256 * j + 4 * lane) = o;
        u32x2 p; p.x = pk2(vb[j][0] * rb * gg[0], vb[j][1] * rb * gg[1]); p.y = pk2(vb[j][2] * rb * gg[2], vb[j][3] * rb * gg[3]); *(u32x2*)(ob + 256 * j + 4 * lane) = p; }
}
DI void norm_row_f32(float* xrow, const float* g, int lane) {
    f32x4 v[4]; float s = 0.f;
#pragma unroll
    for (int j = 0; j < 4; ++j) { v[j] = *(const f32x4*)(xrow + 256 * j + 4 * lane); s += (v[j][0] * v[j][0] + v[j][1] * v[j][1]) + (v[j][2] * v[j][2] + v[j][3] * v[j][3]); }
    const float rs = __builtin_amdgcn_rsqf(wave_sum(s) * (1.f / 1024.f) + EPS);
#pragma unroll
    for (int j = 0; j < 4; ++j) { const f32x4 gg = *(const f32x4*)(g + 256 * j + 4 * lane); *(f32x4*)(xrow + 256 * j + 4 * lane) = v[j] * rs * gg; }
}
DI void unpack8(const u32x4 w, float* f) {
#pragma unroll
    for (int i = 0; i < 4; ++i) { f[2 * i] = __uint_as_float(w[i] << 16); f[2 * i + 1] = __uint_as_float(w[i] & 0xffff0000u); }
}
DI void sincos_acc(float ang, float& sn, float& cs) {
    const double xd = (double)ang; const double k = __builtin_rint(xd * 0.63661977236758134308);
    const float r = (float)(xd - k * 1.57079632679489661923); const int q = ((int)k) & 3; const float r2 = r * r;
    const float s = r + r * r2 * (-1.6666667e-1f + r2 * (8.3333333e-3f + r2 * (-1.9841270e-4f + r2 * 2.7557319e-6f)));
    const float c = 1.f + r2 * (-0.5f + r2 * (4.1666667e-2f + r2 * (-1.3888889e-3f + r2 * (2.4801587e-5f + r2 * -2.7557319e-7f))));
    sn = (q == 0) ? s : (q == 1) ? c : (q == 2) ? -s : -c;
    cs = (q == 0) ? c : (q == 1) ? -s : (q == 2) ? -c : s;
}

#ifndef PHMASK
#define PHMASK 0xFFFFFF
#endif
#define PH(k) ((PHMASK >> (k)) & 1)
#ifndef PHREP
#define PHREP 0x0
#endif
#define REP(k) for (int rep_ = 0; rep_ < (((PHREP >> (k)) & 1) ? 2 : 1); ++rep_)
constexpr int NPHASE = 14;
#ifndef MLA_SD
#define MLA_SD 1
#endif
__global__ void __launch_bounds__(512, 2) fwd_megakernel(Params P) {
    extern __shared__ __attribute__((aligned(16))) unsigned char lds[];
    cg::grid_group grid = cg::this_grid();
    const int G = gridDim.x, bid = blockIdx.x;
    LAS unsigned char* ring = (LAS unsigned char*)lds;
    if (threadIdx.x < 16) ((LAS unsigned*)(ring + MISC_OFF))[threadIdx.x] = 0u;
    __syncthreads();
    if (bid == 0) for (int i = threadIdx.x; i < (int)(CTL_BYTES + 32768) / 4; i += 512) __hip_atomic_store((unsigned*)(P.ws + WS_CTL) + i, 0u, __ATOMIC_RELAXED, __HIP_MEMORY_SCOPE_AGENT);
#define SEAM() xcd_barrier(xbar)
#define PHASE_VARS \
    const int tid = opaque_tid(), lane = tid & 63, wave = __builtin_amdgcn_readfirstlane(tid >> 6); const int gw = bid * 8 + wave, NGW = G * 8; (void)gw; (void)NGW; (void)lane; \
    size_t wz_ = 0; asm volatile("" : "+s"(wz_)); unsigned char* ws = P.ws + wz_;     \
    bf16 *Wt_in = (bf16*)(ws + WS_WIN), *Wt_mkv = (bf16*)(ws + WS_WMKV), *Wt_q = (bf16*)(ws + WS_WQ), *Wt_kv = (bf16*)(ws + WS_WKV), *Wt_out = (bf16*)(ws + WS_WOUT), \
         *Wt_mq = (bf16*)(ws + WS_WMQ), *Wt_mo = (bf16*)(ws + WS_WMO), *Wt_gu = (bf16*)(ws + WS_WGU), *Wt_dn = (bf16*)(ws + WS_WDN); \
    bf16 *HB = (bf16*)(ws + WS_HB), *MK = (bf16*)(ws + WS_MK), *MKV = (bf16*)(ws + WS_MKV), *KPE = (bf16*)(ws + WS_KPE), *OB = (bf16*)(ws + WS_OB), *OA = (bf16*)(ws + WS_OA), \
         *QKV = (bf16*)(ws + WS_QKV), *KVB = (bf16*)(ws + WS_KVB), *QB = (bf16*)(ws + WS_QB), *CQ = (bf16*)(ws + WS_CQ), *CKV = (bf16*)(ws + WS_CKV), \
         *MQ = (bf16*)(ws + WS_MQ), *MO = (bf16*)(ws + WS_MO), *GU = (bf16*)(ws + WS_GU); \
    float *TC = (float*)(ws + WS_TC), *TS = (float*)(ws + WS_TS), *LSE = (float*)(ws + WS_LSE), *SSQ = (float*)(ws + WS_SSQ), *SS1 = (float*)(ws + WS_SS1), *SS2 = (float*)(ws + WS_SS2), *SS3 = (float*)(ws + WS_SS3); \
    bf16 *XB1 = (bf16*)(ws + WS_XB1), *XB2 = (bf16*)(ws + WS_XB2), *X3 = (bf16*)(ws + WS_X3); (void)SS1; (void)SS2; (void)SS3; (void)XB1; (void)XB2; (void)X3; \
    (void)Wt_in; (void)Wt_mkv; (void)Wt_q; (void)Wt_kv; (void)Wt_out; (void)Wt_mq; (void)Wt_mo; (void)Wt_gu; (void)Wt_dn; (void)HB; (void)MK; (void)MKV; (void)KPE; (void)OB; (void)OA; \
    (void)QKV; (void)KVB; (void)QB; (void)CQ; (void)CKV; (void)MQ; (void)MO; (void)GU; (void)TC; (void)TS; (void)LSE; (void)SSQ;

    __syncthreads();
    grid.sync();
    const XcdBarrier xbar = xcd_barrier_post((unsigned*)(P.ws + WS_CTL), (volatile LAS unsigned*)(ring + MISC_OFF));
    if (PH(0)) REP(0) {
        PHASE_VARS
        LAS float* scr = (LAS float*)(ring + wave * 16384);
        constexpr int I0 = 16 * 72, I1 = 16 * 32, I2 = 6 * 24, I3 = 4 * 32, I4 = 16 * 32, I5 = 16 * 16, I6 = 8 * 32, I7 = 16 * 176, I8 = 44 * 32;
        constexpr int NITEMS = I0 + I1 + I2 + I3 + I4 + I5 + I6 + I7 + I8;
        for (int it = gw; it < NITEMS; it += NGW) {
            int r = it;
            if (r < I0) { const int g = r % 72, kb = r / 72; int sc;
                if (g < 64) sc = 32 * g; else if (g == 64) sc = 2048; else if (g == 65) sc = 2080; else if (g == 66) sc = 2176; else if (g == 67) sc = -1;
                else if (g == 68) sc = 2112; else if (g == 69) sc = 2144; else if (g == 70) sc = 2208; else sc = -1;
                transpose_item(P.w_in, 2240, sc, nullptr, Wt_in, 1024, 32 * g, 64 * kb, scr, lane); continue; } r -= I0;
            if (r < I1) { const int g = r % 32, kb = r / 32; transpose_item(P.w_mkv, 1024, 32 * g, nullptr, Wt_mkv, 1024, 32 * g, 64 * kb, scr, lane); continue; } r -= I1;
            if (r < I2) { const int g = r % 24, kb = r / 24; transpose_item(P.w_q_up, 768, 32 * g, P.q_norm, Wt_q, 384, 32 * g, 64 * kb, scr, lane); continue; } r -= I2;
            if (r < I3) { const int g = r % 32, kb = r / 32; transpose_item(P.w_kv_up, 1024, 32 * g, P.kv_norm, Wt_kv, 256, 32 * g, 64 * kb, scr, lane); continue; } r -= I3;
            if (r < I4) { const int g = r % 32, kb = r / 32; transpose_item(P.w_out, 1024, 32 * g, nullptr, Wt_out, 1024, 32 * g, 64 * kb, scr, lane); continue; } r -= I4;
            if (r < I5) { const int g = r % 16, kb = r / 16; transpose_item(P.w_mq, 512, 32 * g, P.norm_mem_q, Wt_mq, 1024, 32 * g, 64 * kb, scr, lane); continue; } r -= I5;
            if (r < I6) { const int g = r % 32, kb = r / 32; transpose_item(P.w_mo, 1024, 32 * g, nullptr, Wt_mo, 512, 32 * g, 64 * kb, scr, lane); continue; } r -= I6;
            if (r < I7) { const int g = r % 176, kb = r / 176; const int pn = g >> 3, bj = (g >> 2) & 1, q = g & 3;
                transpose_item(bj ? P.w_up : P.w_gate, DFF, 128 * pn + 32 * q, P.norm_ffn, Wt_gu, 1024, 32 * g, 64 * kb, scr, lane); continue; } r -= I7;
            { const int g = r % 32, kb = r / 32; transpose_item(P.w_down, 1024, 32 * g, nullptr, Wt_dn, DFF, 32 * g, 64 * kb, scr, lane); }
        }
        { int m = gw;
          for (; m + NGW < T; m += 2 * NGW) norm_row2_bf16(P.x + (size_t)m * 1024, P.x + (size_t)(m + NGW) * 1024, P.norm_mix, HB + (size_t)m * 1024, HB + (size_t)(m + NGW) * 1024, lane);
          for (; m < T; m += NGW) norm_row_bf16(P.x + (size_t)m * 1024, P.norm_mix, HB + (size_t)m * 1024, lane); }
        for (int m = gw; m < TM; m += NGW) norm_row_bf16(P.mem + (size_t)m * 1024, P.norm_mem_kv, MK + (size_t)m * 1024, lane);
        for (int e0 = bid * 512 + tid; e0 < T * 32; e0 += 4 * G * 512) {
            int pp[4];
#pragma unroll
            for (int j = 0; j < 4; ++j) { const int e = e0 + j * G * 512; pp[j] = (e < T * 32) ? P.pos[e >> 5] : 0; }
#pragma unroll
            for (int j = 0; j < 4; ++j) { const int e = e0 + j * G * 512; if (e < T * 32) { const int i = e & 31;
                const float inv = __builtin_exp2f(-(float)i * (13.287712379549449f / 32.f));
                const float ang = (float)pp[j] * inv; float sn, cs; sincos_acc(ang, sn, cs); TC[e] = cs; TS[e] = sn; } } }
        for (int e = bid * 512 + tid; e < 5 * T; e += G * 512) ((float*)(ws + WS_RS2))[e] = 0.f;
    }
    SEAM();
    if (PH(1)) REP(1) {
        PHASE_VARS
        { pg8::Gemm g{HB, Wt_in, T, DIN_PAD, 1024}; pg8::StaticOrder S; S.init(T, DIN_PAD, G, bid);
          epi::Proj E{QKV, CQ, CKV, KPE, (float*)(ws + WS_RS2 + 262144), TC, TS}; pg8::gemm_phase<epi::Proj, pg8::StaticOrder, true, true>(ring, g, S, E); }
        { pg8::Gemm g{MK, Wt_mkv, TM, 1024, 1024}; pg8::StaticOrder S; S.init(TM, 1024, G, (bid + G - 128) % G);
          epi::Plain E{MKV, 1024}; pg8::gemm_phase<epi::Plain, pg8::StaticOrder, true, true>(ring, g, S, E); }
    }
    SEAM();
    if (PH(2)) REP(2) {
        PHASE_VARS
        if (PH(16)) { pg8::Gemm g{CQ, Wt_q, T, 768, QLORA}; pg8::StaticOrder S; S.init(T, 768, G, bid);
          epi::Scaled<0, 0, 384, 2> E{QB, 768, (const float*)(ws + WS_RS2 + 262144)}; pg8::gemm_phase<epi::Scaled<0, 0, 384, 2>, pg8::StaticOrder, true, true>(ring, g, S, E); }
        if (PH(17)) { pg8::Gemm g{CKV, Wt_kv, T, 1024, KVLORA}; pg8::StaticOrder S; S.init(T, 1024, G, (bid + G - 128) % G);
          epi::Scaled<1, 0, 256, 2> E{KVB, 1024, (const float*)(ws + WS_RS2 + 262144)}; pg8::gemm_phase<epi::Scaled<1, 0, 256, 2>, pg8::StaticOrder, true, true>(ring, g, S, E); }
        if (PH(18)) for (int u = bid; u < 3072; u += G) {
            const int br = u >> 10, v = u & 1023, h = v & 7, w = v >> 3;
            const int b = w >> 4, blk = w & 15;
            int d, r, qb; if (br == 0) { d = 1; r = 0; qb = blk; } else if (br == 1) { d = 4; r = blk & 3; qb = blk >> 2; } else { d = 16; r = blk; qb = 0; }
            const float slope = __builtin_exp2f(-(float)(h + 1));
            dil::unit(QKV, P.pos, OA + (size_t)br * T * 512, LSE + (size_t)br * T * 8, b, h, d, r, qb, slope, (char*)lds);
        }
    }
    SEAM();
    if (PH(3)) REP(3) { PHASE_VARS
    for (int u = bid; u < 512; u += G) {
        const int bh = (u & 7) * 4 + (u >> 8) * 2 + (((u >> 3) & 31) >> 4), qb = (u >> 3) & 15, b = bh >> 2, h = bh & 3;
        const size_t t0 = (size_t)b * SEQ;
        att::dense_ring<4, 768, 1024, 128, 512>(QB + (t0 + qb * 256) * 768 + h * 192, KVB + t0 * 1024 + h * 256, KPE + t0 * 64, TC + (t0 + qb * 256) * 32, TS + (t0 + qb * 256) * 32,
                                           OB + (t0 + qb * 256) * 512 + h * 128, SEQ, 0.07216878364870323f, (char*)lds);
    } }
    SEAM();
    if (PH(4)) REP(4) { PHASE_VARS
    for (int m = gw; m < T; m += NGW) {
        const int h = lane >> 3;
        const float l0 = LSE[(size_t)m * 8 + h], l1 = LSE[(size_t)(T + m) * 8 + h], l2 = LSE[(size_t)(2 * T + m) * 8 + h];
        const float mx = fmaxf(l0, fmaxf(l1, l2)); float w0 = __expf(l0 - mx), w1 = __expf(l1 - mx), w2 = __expf(l2 - mx); const float inv = 1.f / (w0 + w1 + w2); w0 *= inv; w1 *= inv; w2 *= inv;
        float a0[8], a1[8], a2[8], ob[8], oa[8];
        unpack8(*(const u32x4*)(OA + (size_t)m * 512 + 8 * lane), a0); unpack8(*(const u32x4*)(OA + (size_t)(T + m) * 512 + 8 * lane), a1); unpack8(*(const u32x4*)(OA + (size_t)(2 * T + m) * 512 + 8 * lane), a2);
        unpack8(*(const u32x4*)(OB + (size_t)m * 512 + 8 * lane), ob);
        float sa = 0.f, sb = 0.f;
#pragma unroll
        for (int i = 0; i < 8; ++i) { oa[i] = w0 * a0[i] + w1 * a1[i] + w2 * a2[i]; sa += oa[i] * oa[i]; sb += ob[i] * ob[i]; }
        const float ra = __builtin_amdgcn_rsqf(wave_sum(sa) * (1.f / 512.f) + EPS), rb = __builtin_amdgcn_rsqf(wave_sum(sb) * (1.f / 512.f) + EPS);
        const f32x4 ga0 = *(const f32x4*)(P.gout_a + 8 * lane), ga1 = *(const f32x4*)(P.gout_a + 8 * lane + 4), gb0 = *(const f32x4*)(P.gout_b + 8 * lane), gb1 = *(const f32x4*)(P.gout_b + 8 * lane + 4);
        u32x4 wa, wb;
        wa.x = pk2(oa[0] * ra * ga0[0], oa[1] * ra * ga0[1]); wa.y = pk2(oa[2] * ra * ga0[2], oa[3] * ra * ga0[3]); wa.z = pk2(oa[4] * ra * ga1[0], oa[5] * ra * ga1[1]); wa.w = pk2(oa[6] * ra * ga1[2], oa[7] * ra * ga1[3]);
        wb.x = pk2(ob[0] * rb * gb0[0], ob[1] * rb * gb0[1]); wb.y = pk2(ob[2] * rb * gb0[2], ob[3] * rb * gb0[3]); wb.z = pk2(ob[4] * rb * gb1[0], ob[5] * rb * gb1[1]); wb.w = pk2(ob[6] * rb * gb1[2], ob[7] * rb * gb1[3]);
        *(u32x4*)(HB + (size_t)m * 1024 + 8 * lane) = wa; *(u32x4*)(HB + (size_t)m * 1024 + 512 + 8 * lane) = wb;
    } }
    SEAM();
    if (PH(5)) REP(5) { PHASE_VARS pg8::Gemm g{HB, Wt_out, T, 1024, 1024}; pg8::StaticOrder S; S.init(T, 1024, G, bid);
      epi::ResS<true, true> E{P.x, XB1, (float*)(ws + WS_RS2 + 131072)}; pg8::gemm_phase<epi::ResS<true, true>, pg8::StaticOrder, true, true>(ring, g, S, E); }
    SEAM();
    if (PH(7)) { PHASE_VARS pg8::Gemm g{XB1, Wt_mq, T, 512, 1024}; pg8::StaticOrder S; S.init(T, 512, G, bid);
      epi::Scaled<0, 0, 1024, 1> E{MQ, 512, (const float*)(ws + WS_RS2 + 131072)}; pg8::gemm_phase<epi::Scaled<0, 0, 1024, 1>, pg8::StaticOrder, true, true>(ring, g, S, E);
      if (G == 256) {
        asm volatile("s_waitcnt vmcnt(0)" ::: "memory"); __syncthreads();
        const int wg = (bid & 7) * 32 + (bid >> 3), pm = (wg >> 4) * 8 + (wg & 7), pn = (wg >> 3) & 1;
        for (int hs = 0; hs < 2; ++hs) { const int h = 2 * pn + hs, b = pm >> 4; const size_t t0 = (size_t)pm * 256;
          att::dense_ring<0, 512, 1024, 512, 512>(MQ + t0 * 512 + h * 128, MKV + (size_t)b * NMEM * 1024 + h * 128, nullptr, nullptr, nullptr,
                                                  MO + t0 * 512 + h * 128, NMEM, 0.08838834764831845f, (char*)lds); }
      }
    }
    if (G != 256) {
    SEAM();
    if (PH(8)) { PHASE_VARS
    for (int u = bid; u < 512; u += G) {
        const int h = u & 3, qb = (u >> 2) & 15, b = u >> 6; const size_t t0 = (size_t)b * SEQ + qb * 256;
        att::dense_ring<0, 512, 1024, 512, 512>(MQ + t0 * 512 + h * 128, MKV + (size_t)b * NMEM * 1024 + h * 128, nullptr, nullptr, nullptr,
                                           MO + t0 * 512 + h * 128, NMEM, 0.08838834764831845f, (char*)lds);
    } }
    }
    SEAM();
    if (PH(9)) REP(9) { PHASE_VARS pg8::Gemm g{MO, Wt_mo, T, 1024, 512}; pg8::StaticOrder S; S.init(T, 1024, G, bid);
      epi::ResS<false, true> E{XB1, XB2, (float*)(ws + WS_RS2)}; pg8::gemm_phase<epi::ResS<false, true>, pg8::StaticOrder, true, true>(ring, g, S, E); }
    SEAM();
    if (PH(11)) REP(11) { PHASE_VARS pg8::Gemm g{XB2, Wt_gu, T, 2 * DFF, 1024}; pg8::StaticOrder S; S.init(T, 2 * DFF, G, bid);
      epi::SwiGLU E{GU, (const float*)(ws + WS_RS2)}; pg8::gemm_phase<epi::SwiGLU, pg8::StaticOrder, true, true>(ring, g, S, E); }
    SEAM();
    const bool fuse_final = (G == 256);
    if (PH(12)) { PHASE_VARS pg8::Gemm g{GU, Wt_dn, T, 1024, DFF}; pg8::StaticOrder S; S.init(T, 1024, G, bid);
      if (fuse_final) { epi::ResFinal E{XB2, P.out, (float*)(ws + WS_RS2 + 524288), (unsigned*)(ws + WS_PCNT), P.norm_final}; pg8::gemm_phase<epi::ResFinal, pg8::StaticOrder, true, true>(ring, g, S, E); }
      else { epi::ResS<false> E{XB2, X3, SS3}; pg8::gemm_phase<epi::ResS<false>, pg8::StaticOrder, true, true>(ring, g, S, E); } }
    if (fuse_final) return;
    SEAM();
    if (PH(13)) { PHASE_VARS
    for (int m = gw; m < T; m += NGW) {
        float ss = 0.f;
#pragma unroll
        for (int q = 0; q < 4; ++q) { const f32x4 v = *(const f32x4*)(SS3 + (size_t)m * 16 + 4 * q); ss += (v[0] + v[1]) + (v[2] + v[3]); }
        const float rs = __builtin_amdgcn_rsqf(ss * (1.f / 1024.f) + EPS);
#pragma unroll
        for (int hf = 0; hf < 2; ++hf) { float xv[8]; unpack8(*(const u32x4*)(X3 + (size_t)m * 1024 + hf * 512 + 8 * lane), xv);
            const f32x4 g0 = *(const f32x4*)(P.norm_final + hf * 512 + 8 * lane), g1 = *(const f32x4*)(P.norm_final + hf * 512 + 8 * lane + 4);
            *(f32x4*)(P.out + (size_t)m * 1024 + hf * 512 + 8 * lane) = (f32x4){xv[0] * rs * g0[0], xv[1] * rs * g0[1], xv[2] * rs * g0[2], xv[3] * rs * g0[3]};
            *(f32x4*)(P.out + (size_t)m * 1024 + hf * 512 + 8 * lane + 4) = (f32x4){xv[4] * rs * g1[0], xv[5] * rs * g1[1], xv[6] * rs * g1[2], xv[7] * rs * g1[3]}; }
    } }
}

extern "C" void kernel_launch(void* const* d_in, const int* in_sizes, int n_in, void* d_out, int out_size, void* d_ws, size_t ws_size, hipStream_t stream) {
    static int grid_blocks = 0;
    if (grid_blocks == 0) {
        if (n_in != 22 || in_sizes[0] != T * DM || out_size != T * DM || ws_size < WS_END) {
            fprintf(stderr, "kernel_launch: shape mismatch n_in %d in0 %d out %d ws %zu (need %zu)\n", n_in, n_in > 0 ? in_sizes[0] : -1, out_size, ws_size, (size_t)WS_END); grid_blocks = -1; return; }
        int dev = 0, cus = 0, per_cu = 0;
        hipGetDevice(&dev); hipDeviceGetAttribute(&cus, hipDeviceAttributeMultiprocessorCount, dev);
        if (hipFuncSetAttribute((const void*)fwd_megakernel, hipFuncAttributeMaxDynamicSharedMemorySize, LDS_BYTES) != hipSuccess) { fprintf(stderr, "kernel_launch: hipFuncSetAttribute failed\n"); grid_blocks = -1; return; }
        if (hipOccupancyMaxActiveBlocksPerMultiprocessor(&per_cu, (const void*)fwd_megakernel, 512, LDS_BYTES) != hipSuccess || per_cu < 1) { fprintf(stderr, "kernel_launch: occupancy query failed (%d)\n", per_cu); per_cu = 1; }
        (void)hipGetLastError();
        grid_blocks = cus * (per_cu > 1 ? 1 : per_cu);
        if (grid_blocks % 8 != 0 || grid_blocks < 136) fprintf(stderr, "kernel_launch: unexpected grid %d\n", grid_blocks);
    }
    if (grid_blocks < 0) return;
    Params p{};
    p.x = (const float*)d_in[0]; p.mem = (const float*)d_in[1]; p.pos = (const int*)d_in[2];
    p.norm_mix = (const float*)d_in[3]; p.w_in = (const float*)d_in[4]; p.q_norm = (const float*)d_in[5]; p.w_q_up = (const float*)d_in[6]; p.kv_norm = (const float*)d_in[7];
    p.w_kv_up = (const float*)d_in[8]; p.gout_a = (const float*)d_in[9]; p.gout_b = (const float*)d_in[10]; p.w_out = (const float*)d_in[11]; p.norm_mem_q = (const float*)d_in[12];
    p.norm_mem_kv = (const float*)d_in[13]; p.w_mq = (const float*)d_in[14]; p.w_mkv = (const float*)d_in[15]; p.w_mo = (const float*)d_in[16]; p.norm_ffn = (const float*)d_in[17];
    p.w_gate = (const float*)d_in[18]; p.w_up = (const float*)d_in[19]; p.w_down = (const float*)d_in[20]; p.norm_final = (const float*)d_in[21];
    p.out = (float*)d_out; p.ws = (unsigned char*)d_ws;
    void* args[] = {&p};
    hipError_t e = hipLaunchCooperativeKernel((const void*)fwd_megakernel, dim3(grid_blocks), dim3(512), args, LDS_BYTES, stream);
    if (e != hipSuccess) fprintf(stderr, "cooperative launch failed: %s (grid %d)\n", hipGetErrorString(e), grid_blocks);
}
```

```cpp
#include <hip/hip_runtime.h>
#include <hip/hip_cooperative_groups.h>
#include <cstdio>
#include <cstdint>
namespace cg = cooperative_groups;
#define DI __device__ __forceinline__
__device__ __forceinline__ int opaque_tid() { int t = threadIdx.x; asm volatile("" : "+v"(t)); return t; }

namespace pg8 {
#define PG8_LAS __attribute__((address_space(3)))
typedef unsigned short bf16_t;
typedef short bf16x8 __attribute__((ext_vector_type(8)));
typedef float f32x4 __attribute__((ext_vector_type(4)));
typedef unsigned u32x4 __attribute__((ext_vector_type(4)));
constexpr int BM = 256, BK = 64, HALF = 128, HTB = HALF * BK * 2  , STAGE_BYTES = 8 * HTB, NXCD = 8, WGM = 8;

__host__ __device__ __forceinline__ int lds_byte(int r, int c) { const int st = (r >> 4) * 2 + (c >> 5), rr = r & 15, cc = c & 31, ob = rr * 64 + cc * 2; return st * 1024 + (ob ^ (((ob >> 9) & 1) << 5)); }
__host__ __device__ __forceinline__ void stage_rc(int b, int& R, int& C) { const int st = b / 1024, sb = b % 1024, swz = sb ^ (((sb >> 9) & 1) << 5); R = (st >> 1) * 16 + swz / 64; C = (st & 1) * 32 + (swz % 64) / 2; }
__host__ __device__ __forceinline__ int perm32(int rho) { const int n = rho >> 4, i = rho & 15; return 8 * (i >> 2) + 4 * n + (i & 3); }

struct Unit { int pm, pn; };
struct Gemm { const bf16_t* A; const bf16_t* Bt; int M, N, K; };

struct StaticOrder {
    int nM, nN, nwg, G, c;
    __host__ __device__ void init(int M, int N, int G_, int c_) { nM = M / BM; nN = N / BM; nwg = nM * nN; G = G_; c = c_; }
    __host__ __device__ bool next(int i, Unit& u) const {
        const long L = (long)i * G + c; if (L >= nwg) return false;
        int wgid = (int)L; { const int q = nwg / NXCD, r = nwg % NXCD, xcd = wgid % NXCD, off = wgid / NXCD; wgid = (xcd < r ? xcd * (q + 1) : r * (q + 1) + (xcd - r) * q) + off; }
        const int nig = WGM * nN, gid = wgid / nig, fm = gid * WGM, gsz = (nM - fm) < WGM ? (nM - fm) : WGM;
        u.pm = fm + ((wgid % nig) % gsz); u.pn = (wgid % nig) / gsz; return true;
    }
    __device__ __forceinline__ void a_ready(const Unit&) const {}
    __device__ __forceinline__ void done(const Unit&) const {}
};

typedef unsigned u32x2 __attribute__((ext_vector_type(2)));
__device__ __forceinline__ unsigned cvt_pk_bf16(float lo, float hi) { unsigned r; asm("v_cvt_pk_bf16_f32 %0, %1, %2" : "=v"(r) : "v"(lo), "v"(hi)); return r; }
template <class Epi, class Sched, bool ALIGN_EPI = false, bool SP2 = false>
__device__ __forceinline__ void gemm_phase(PG8_LAS unsigned char* lds, const Gemm g, const Sched& S, const Epi& E) {
    const int tid = opaque_tid(), wid = __builtin_amdgcn_readfirstlane(tid >> 6), lane = tid & 63, wr = wid >> 2, wc = wid & 3, fr = lane & 15, fq = lane >> 4;
    const int K = g.K, nt = K / BK;
    unsigned voffA[2], voffB[2];
#pragma unroll
    for (int i = 0; i < 2; ++i) { int R, C; stage_rc(tid * 16 + i * 8192, R, C); const int Rb = Epi::PERM ? ((R & ~31) + perm32(R & 31)) : R;
        voffA[i] = (unsigned)(R * K + C) * 2u; voffB[i] = (unsigned)(Rb * K + C) * 2u; }
    const size_t kstep = (size_t)(BK * 2);
    const size_t hstep = (size_t)HALF * K * 2;
    const size_t tstep = 2 * hstep;
    const unsigned ldsw = (unsigned)wid * 1024u;
    const int aoff = lds_byte(wr * 64 + fr, fq * 8), boff = lds_byte(wc * 32 + fr, fq * 8);
#define PG8_SA(b, h) (((b) * 2 + (h)) * HTB)
#define PG8_SB(b, h) ((4 + (b) * 2 + (h)) * HTB)
#define PG8_STAGE(bufoff, gbase, voff) do { _Pragma("unroll") for (int _i = 0; _i < 2; ++_i) \
        __builtin_amdgcn_global_load_lds((const unsigned*)((const char*)(gbase) + (voff)[_i]), (PG8_LAS unsigned*)(lds + (bufoff) + ldsw + _i * 8192), 16, 0, 0); } while (0)
#define PG8_LDA(dst, b, h) do { _Pragma("unroll") for (int m = 0; m < 4; ++m) _Pragma("unroll") for (int k = 0; k < 2; ++k) dst[m][k] = *(const PG8_LAS bf16x8*)(lds + PG8_SA(b, h) + aoff + m * 2048 + k * 1024); } while (0)
#define PG8_LDB(dst, b, h) do { _Pragma("unroll") for (int n = 0; n < 2; ++n) _Pragma("unroll") for (int k = 0; k < 2; ++k) dst[n][k] = *(const PG8_LAS bf16x8*)(lds + PG8_SB(b, h) + boff + n * 2048 + k * 1024); } while (0)
#define PG8_MMA(ai, bj, At, Bt) do { __builtin_amdgcn_s_setprio(1); _Pragma("unroll") for (int m = 0; m < 4; ++m) _Pragma("unroll") for (int n = 0; n < 2; ++n) _Pragma("unroll") for (int k = 0; k < 2; ++k) \
        acc[ai][bj][m][n] = __builtin_amdgcn_mfma_f32_16x16x32_bf16(Bt[n][k], At[m][k], acc[ai][bj][m][n], 0, 0, 0); __builtin_amdgcn_s_setprio(0); } while (0)
#define PG8_WAIT_V(n) asm volatile("s_waitcnt vmcnt(" #n ")" ::: "memory")
#define PG8_WAIT_L(n) asm volatile("s_waitcnt lgkmcnt(" #n ")" ::: "memory")
#define PG8_BAR __builtin_amdgcn_s_barrier()
#define PG8_SCHED __builtin_amdgcn_sched_barrier(0)
    Unit cur, nxt; int ui = 0;
    if (!S.next(0, cur)) return;
    f32x4 acc[2][2][4][2];
#pragma unroll
    for (int a = 0; a < 2; ++a)
#pragma unroll
        for (int b = 0; b < 2; ++b)
#pragma unroll
            for (int m = 0; m < 4; ++m)
#pragma unroll
                for (int n = 0; n < 2; ++n) acc[a][b][m][n] = (f32x4){0.f, 0.f, 0.f, 0.f};
    bf16x8 At[4][2], B0[2][2], B1[2][2];
    const char* cA = (const char*)g.A + (size_t)cur.pm * tstep; const char* cB = (const char*)g.Bt + (size_t)cur.pn * tstep;
    S.a_ready(cur);
    if constexpr (SP2) {
        PG8_STAGE(PG8_SB(0, 0), cB, voffB); PG8_STAGE(PG8_SB(0, 1), cB + hstep, voffB); PG8_STAGE(PG8_SA(0, 0), cA, voffA); PG8_STAGE(PG8_SA(0, 1), cA + hstep, voffA);
        if (wr == 1) PG8_BAR;
        PG8_WAIT_V(2); PG8_BAR;
        PG8_STAGE(PG8_SB(1, 0), cB + kstep, voffB); PG8_STAGE(PG8_SA(1, 0), cA + kstep, voffA); PG8_STAGE(PG8_SB(1, 1), cB + hstep + kstep, voffB);
        PG8_WAIT_V(6); PG8_BAR;
    } else {
        PG8_STAGE(PG8_SB(0, 0), cB, voffB); PG8_STAGE(PG8_SA(0, 0), cA, voffA); PG8_STAGE(PG8_SB(0, 1), cB + hstep, voffB); PG8_STAGE(PG8_SA(0, 1), cA + hstep, voffA);
        if (wr == 1) PG8_BAR;
        PG8_WAIT_V(4); PG8_BAR;
        PG8_STAGE(PG8_SB(1, 0), cB + kstep, voffB); PG8_STAGE(PG8_SA(1, 0), cA + kstep, voffA); PG8_STAGE(PG8_SB(1, 1), cB + hstep + kstep, voffB);
        PG8_WAIT_V(6); PG8_BAR;
    }
    for (;;) {
        const bool has_next = S.next(ui + 1, nxt);
        const char* nA = has_next ? (const char*)g.A + (size_t)nxt.pm * tstep : cA; const char* nB = has_next ? (const char*)g.Bt + (size_t)nxt.pn * tstep : cB;
#pragma unroll 1
        for (int t = 0; t < nt; t += 2) {
            const bool last = (t == nt - 2);
            const char* a1 = cA + (size_t)(t + 1) * kstep;
            const char* a2 = last ? nA : cA + (size_t)(t + 2) * kstep; const char* b2 = last ? nB : cB + (size_t)(t + 2) * kstep;
            const char* a3 = a2 + kstep; const char* b3 = b2 + kstep;
            if (last && has_next) S.a_ready(nxt);
            if constexpr (SP2) {
            PG8_LDB(B0, 0, 0); PG8_LDB(B1, 0, 1); PG8_SCHED; PG8_LDA(At, 0, 0); PG8_STAGE(PG8_SA(1, 1), a1 + hstep, voffA);
            PG8_WAIT_V(8); PG8_WAIT_L(0); PG8_BAR; PG8_MMA(0, 0, At, B0); PG8_MMA(0, 1, At, B1); PG8_BAR; PG8_SCHED;
            PG8_LDA(At, 0, 1); PG8_STAGE(PG8_SB(0, 0), b2, voffB); PG8_STAGE(PG8_SB(0, 1), b2 + hstep, voffB); PG8_STAGE(PG8_SA(0, 0), a2, voffA);
            PG8_WAIT_V(8); PG8_WAIT_L(0); PG8_BAR; PG8_MMA(1, 0, At, B0); PG8_MMA(1, 1, At, B1); PG8_BAR; PG8_SCHED;
            PG8_LDB(B0, 1, 0); PG8_LDB(B1, 1, 1); PG8_SCHED; PG8_LDA(At, 1, 0); PG8_STAGE(PG8_SA(0, 1), a2 + hstep, voffA);
            PG8_WAIT_V(8); PG8_WAIT_L(0); PG8_BAR; PG8_MMA(0, 0, At, B0); PG8_MMA(0, 1, At, B1); PG8_BAR; PG8_SCHED;
            PG8_LDA(At, 1, 1); PG8_STAGE(PG8_SB(1, 0), b3, voffB); PG8_STAGE(PG8_SB(1, 1), b3 + hstep, voffB); PG8_STAGE(PG8_SA(1, 0), a3, voffA);
            PG8_WAIT_V(8); PG8_WAIT_L(0); PG8_BAR; PG8_MMA(1, 0, At, B0); PG8_MMA(1, 1, At, B1); PG8_BAR; PG8_SCHED;
            } else {
            PG8_LDB(B0, 0, 0); PG8_SCHED; PG8_LDA(At, 0, 0); PG8_STAGE(PG8_SA(1, 1), a1 + hstep, voffA);
            PG8_WAIT_L(8); PG8_BAR; PG8_WAIT_L(0); PG8_MMA(0, 0, At, B0); PG8_BAR; PG8_SCHED;
            PG8_LDB(B1, 0, 1); PG8_STAGE(PG8_SB(0, 0), b2, voffB);
            PG8_BAR; PG8_WAIT_L(0); PG8_MMA(0, 1, At, B1); PG8_BAR;
            PG8_LDA(At, 0, 1); PG8_STAGE(PG8_SA(0, 0), a2, voffA);
            PG8_BAR; PG8_WAIT_L(0); PG8_MMA(1, 0, At, B0); PG8_BAR; PG8_SCHED;
            PG8_STAGE(PG8_SB(0, 1), b2 + hstep, voffB);
            PG8_WAIT_V(6); PG8_BAR; PG8_MMA(1, 1, At, B1); PG8_BAR;
            PG8_LDB(B0, 1, 0); PG8_SCHED; PG8_LDA(At, 1, 0); PG8_STAGE(PG8_SA(0, 1), a2 + hstep, voffA);
            PG8_WAIT_L(8); PG8_BAR; PG8_WAIT_L(0); PG8_MMA(0, 0, At, B0); PG8_BAR; PG8_SCHED;
            PG8_LDB(B1, 1, 1); PG8_STAGE(PG8_SB(1, 0), b3, voffB);
            PG8_BAR; PG8_WAIT_L(0); PG8_MMA(0, 1, At, B1); PG8_BAR;
            PG8_LDA(At, 1, 1); PG8_STAGE(PG8_SA(1, 0), a3, voffA);
            PG8_BAR; PG8_WAIT_L(0); PG8_MMA(1, 0, At, B0); PG8_BAR; PG8_SCHED;
            PG8_STAGE(PG8_SB(1, 1), b3 + hstep, voffB);
            PG8_WAIT_V(6); PG8_BAR; PG8_MMA(1, 1, At, B1); PG8_BAR;
            }
        }
        if constexpr (ALIGN_EPI) { if (wr == 0) PG8_BAR; }
        if constexpr (!Epi::AFTER_DRAIN) { E(acc, cur, wr, wc, fr, fq); S.done(cur); }
        if (!has_next) break;
#pragma unroll
        for (int a = 0; a < 2; ++a)
#pragma unroll
            for (int b = 0; b < 2; ++b)
#pragma unroll
                for (int m = 0; m < 4; ++m)
#pragma unroll
                    for (int n = 0; n < 2; ++n) acc[a][b][m][n] = (f32x4){0.f, 0.f, 0.f, 0.f};
        cur = nxt; cA = nA; cB = nB; ++ui;
        if constexpr (ALIGN_EPI) { if (wr == 1) PG8_BAR; }
    }
    PG8_WAIT_V(0);
    if constexpr (!ALIGN_EPI) { if (wr == 0) PG8_BAR; }
    PG8_BAR;
    if constexpr (Epi::AFTER_DRAIN) { E.fused(acc, cur, wr, wc, fr, fq, lds, wid, lane); S.done(cur); }
#undef PG8_SA
#undef PG8_SB
#undef PG8_STAGE
#undef PG8_LDA
#undef PG8_LDB
#undef PG8_MMA
#undef PG8_WAIT_V
#undef PG8_WAIT_L
#undef PG8_BAR
#undef PG8_SCHED
}
}

constexpr int NB = 8, SEQ = 4096, DM = 1024, T = NB * SEQ, NMEM = 256, TM = NB * NMEM;
constexpr int DIN_PAD = 2304, QLORA = 384, KVLORA = 256, DFF = 2816;
constexpr float EPS = 1e-6f;
typedef unsigned short bf16;
typedef short bf16x8 __attribute__((ext_vector_type(8)));
typedef short s16x4 __attribute__((ext_vector_type(4)));
typedef float f32x4 __attribute__((ext_vector_type(4)));
typedef float f32x16 __attribute__((ext_vector_type(16)));
typedef unsigned u32x4 __attribute__((ext_vector_type(4)));
typedef unsigned u32x2 __attribute__((ext_vector_type(2)));
#define LAS __attribute__((address_space(3)))

namespace epi {
using pg8::Unit; using pg8::cvt_pk_bf16;
DI u32x4 pack8(const f32x4 v0, const f32x4 v1) { u32x4 w; w.x = cvt_pk_bf16(v0[0], v0[1]); w.y = cvt_pk_bf16(v0[2], v0[3]); w.z = cvt_pk_bf16(v1[0], v1[1]); w.w = cvt_pk_bf16(v1[2], v1[3]); return w; }
DI float sq8(const f32x4 a, const f32x4 b) { return (a[0]*a[0] + a[1]*a[1]) + (a[2]*a[2] + a[3]*a[3]) + (b[0]*b[0] + b[1]*b[1]) + (b[2]*b[2] + b[3]*b[3]); }

struct Plain {
    static constexpr bool PERM = true, AFTER_DRAIN = false;
    bf16* O; int ldc;
    DI void operator()(const f32x4 (&acc)[2][2][4][2], const Unit& u, int wr, int wc, int fr, int fq) const {
        const int row0 = u.pm * 256 + wr * 64 + fr, col0 = u.pn * 256 + wc * 32 + 8 * fq;
#pragma unroll
        for (int ai = 0; ai < 2; ++ai)
#pragma unroll
            for (int m = 0; m < 4; ++m) { bf16* rowp = O + (size_t)(row0 + ai * 128 + m * 16) * ldc + col0;
#pragma unroll
                for (int bj = 0; bj < 2; ++bj) *(u32x4*)(rowp + bj * 128) = pack8(acc[ai][bj][m][0], acc[ai][bj][m][1]); }
    }
};
struct Proj {
    static constexpr bool PERM = true, AFTER_DRAIN = false;
    bf16 *QKV, *CQ, *CKV, *KPE; float* SSQ; const float *TC, *TS;
    DI void operator()(const f32x4 (&acc)[2][2][4][2], const Unit& u, int wr, int wc, int fr, int fq) const {
        const int row0 = u.pm * 256 + wr * 64 + fr, lc = wc * 32 + 8 * fq;
        if (u.pn < 6) {
#pragma unroll
            for (int ai = 0; ai < 2; ++ai)
#pragma unroll
                for (int m = 0; m < 4; ++m) { const int grow = row0 + ai * 128 + m * 16, bb = grow >> 12, tt = grow & 4095;
#pragma unroll
                    for (int bj = 0; bj < 2; ++bj) { const int hh = (u.pn & 1) * 4 + bj * 2 + (wc >> 1);
                        __builtin_nontemporal_store(pack8(acc[ai][bj][m][0], acc[ai][bj][m][1]), (u32x4*)(QKV + ((size_t)(((u.pn >> 1) * NB + bb) * 8 + hh) * SEQ + tt) * 64 + (wc & 1) * 32 + 8 * fq)); } }
            return;
        }
#pragma unroll
        for (int ai = 0; ai < 2; ++ai)
#pragma unroll
            for (int m = 0; m < 4; ++m) {
                const size_t row = (size_t)(row0 + ai * 128 + m * 16);
                if (u.pn == 8 && wc >= 2) {
                    if (wc == 2) {
                        const f32x4 c0 = *(const f32x4*)(TC + row * 32 + 8 * fq), c1 = *(const f32x4*)(TC + row * 32 + 8 * fq + 4);
                        const f32x4 s0 = *(const f32x4*)(TS + row * 32 + 8 * fq), s1 = *(const f32x4*)(TS + row * 32 + 8 * fq + 4);
                        const f32x4 a0 = acc[ai][0][m][0], a1 = acc[ai][0][m][1], b0 = acc[ai][1][m][0], b1 = acc[ai][1][m][1];
                        *(u32x4*)(KPE + row * 64 + 8 * fq) = pack8(a0 * c0 - b0 * s0, a1 * c1 - b1 * s1);
                        *(u32x4*)(KPE + row * 64 + 32 + 8 * fq) = pack8(b0 * c0 + a0 * s0, b1 * c1 + a1 * s1);
                    }
                    continue;
                }
#pragma unroll
                for (int bj = 0; bj < 2; ++bj) {
                    const f32x4 v0 = acc[ai][bj][m][0], v1 = acc[ai][bj][m][1];
                    bf16* dst; int slot;
                    if (u.pn == 6)      { dst = CQ + row * 384 + bj * 128 + lc; slot = 4 * bj + wc; }
                    else if (u.pn == 7) { if (bj == 0) { dst = CQ + row * 384 + 256 + lc; slot = 8 + wc; } else { dst = CKV + row * 256 + lc; slot = 12 + wc; } }
                    else                { dst = CKV + row * 256 + 128 + 64 * bj + lc; slot = 16 + 2 * bj + wc; }
                    *(u32x4*)dst = pack8(v0, v1);
                    float s = sq8(v0, v1); s += __shfl_xor(s, 16); s += __shfl_xor(s, 32);
                    if (fq == 0) unsafeAtomicAdd(SSQ + row * 2 + (slot >= 12 ? 1 : 0), s);
                }
            }
    }
};
template <int SLOT0, int NQ, int KDIM, int LDS_ = 32> struct Scaled {
    static constexpr bool PERM = true, AFTER_DRAIN = false;
    bf16* O; int ldc; const float* SSQ;
    DI void operator()(const f32x4 (&acc)[2][2][4][2], const Unit& u, int wr, int wc, int fr, int fq) const {
        const int row0 = u.pm * 256 + wr * 64 + fr, col0 = u.pn * 256 + wc * 32 + 8 * fq;
#pragma unroll
        for (int ai = 0; ai < 2; ++ai)
#pragma unroll
            for (int m = 0; m < 4; ++m) {
                const size_t row = (size_t)(row0 + ai * 128 + m * 16);
                float ss = 0.f;
                if constexpr (NQ == 0) ss = SSQ[row * LDS_ + SLOT0];
#pragma unroll
                for (int q = 0; q < NQ; ++q) { const f32x4 v = *(const f32x4*)(SSQ + row * LDS_ + SLOT0 + 4 * q); ss += (v[0] + v[1]) + (v[2] + v[3]); }
                const float rs = __builtin_amdgcn_rsqf(ss * (1.0f / KDIM) + EPS);
#pragma unroll
                for (int bj = 0; bj < 2; ++bj) *(u32x4*)(O + row * ldc + col0 + bj * 128) = pack8(acc[ai][bj][m][0] * rs, acc[ai][bj][m][1] * rs);
            }
    }
};
template <bool IN_F32, bool ATOM = false> struct ResS {
    static constexpr bool PERM = true, AFTER_DRAIN = false;
    const void* XI; bf16* XO; float* SS;
    DI void operator()(const f32x4 (&acc)[2][2][4][2], const Unit& u, int wr, int wc, int fr, int fq) const {
        const int row0 = u.pm * 256 + wr * 64 + fr, col0 = u.pn * 256 + wc * 32 + 8 * fq;
        if constexpr (IN_F32) {
#pragma unroll
            for (int ai = 0; ai < 2; ++ai) {
                f32x4 xr[4][2][2];
#pragma unroll
                for (int m = 0; m < 4; ++m)
#pragma unroll
                    for (int bj = 0; bj < 2; ++bj) { const float* p = (const float*)XI + (size_t)(row0 + ai * 128 + m * 16) * 1024 + col0 + bj * 128; xr[m][bj][0] = *(const f32x4*)p; xr[m][bj][1] = *(const f32x4*)(p + 4); }
#pragma unroll
                for (int m = 0; m < 4; ++m) { const size_t row = (size_t)(row0 + ai * 128 + m * 16), off = row * 1024 + col0; float sq = 0.f;
#pragma unroll
                    for (int bj = 0; bj < 2; ++bj) { const f32x4 v0 = xr[m][bj][0] + acc[ai][bj][m][0], v1 = xr[m][bj][1] + acc[ai][bj][m][1];
                        *(u32x4*)(XO + off + bj * 128) = pack8(v0, v1); sq += sq8(v0, v1); }
                    sq += __shfl_xor(sq, 16); sq += __shfl_xor(sq, 32);
                    if (fq == 0) { if constexpr (ATOM) unsafeAtomicAdd(SS + row, sq); else SS[row * 16 + 4 * u.pn + wc] = sq; } }
            }
        } else {
            u32x4 xw[2][4][2];
#pragma unroll
            for (int ai = 0; ai < 2; ++ai)
#pragma unroll
                for (int m = 0; m < 4; ++m)
#pragma unroll
                    for (int bj = 0; bj < 2; ++bj) xw[ai][m][bj] = *(const u32x4*)((const bf16*)XI + (size_t)(row0 + ai * 128 + m * 16) * 1024 + col0 + bj * 128);
#pragma unroll
            for (int ai = 0; ai < 2; ++ai)
#pragma unroll
                for (int m = 0; m < 4; ++m) { const size_t row = (size_t)(row0 + ai * 128 + m * 16), off = row * 1024 + col0; float sq = 0.f;
#pragma unroll
                    for (int bj = 0; bj < 2; ++bj) { const u32x4 w = xw[ai][m][bj];
                        const f32x4 x0 = (f32x4){__uint_as_float(w[0] << 16), __uint_as_float(w[0] & 0xffff0000u), __uint_as_float(w[1] << 16), __uint_as_float(w[1] & 0xffff0000u)};
                        const f32x4 x1 = (f32x4){__uint_as_float(w[2] << 16), __uint_as_float(w[2] & 0xffff0000u), __uint_as_float(w[3] << 16), __uint_as_float(w[3] & 0xffff0000u)};
                        const f32x4 v0 = x0 + acc[ai][bj][m][0], v1 = x1 + acc[ai][bj][m][1];
                        *(u32x4*)(XO + off + bj * 128) = pack8(v0, v1); sq += sq8(v0, v1); }
                    sq += __shfl_xor(sq, 16); sq += __shfl_xor(sq, 32);
                    if (fq == 0) { if constexpr (ATOM) unsafeAtomicAdd(SS + row, sq); else SS[row * 16 + 4 * u.pn + wc] = sq; } }
        }
    }
};
struct ResFinal {
    static constexpr bool PERM = true, AFTER_DRAIN = false;
    const bf16* XI; float* OUT; float* SS; unsigned* cnt; const float* gain;
    DI void operator()(const f32x4 (&acc_)[2][2][4][2], const Unit& u, int wr, int wc, int fr, int fq) const {
        f32x4 (&acc)[2][2][4][2] = const_cast<f32x4 (&)[2][2][4][2]>(acc_);
        const int row0 = u.pm * 256 + wr * 64 + fr, col0 = u.pn * 256 + wc * 32 + 8 * fq;
        u32x4 xw[2][4][2];
#pragma unroll
        for (int ai = 0; ai < 2; ++ai)
#pragma unroll
            for (int m = 0; m < 4; ++m)
#pragma unroll
                for (int bj = 0; bj < 2; ++bj) xw[ai][m][bj] = *(const u32x4*)(XI + (size_t)(row0 + ai * 128 + m * 16) * 1024 + col0 + bj * 128);
#pragma unroll
        for (int ai = 0; ai < 2; ++ai)
#pragma unroll
            for (int m = 0; m < 4; ++m) { const size_t row = (size_t)(row0 + ai * 128 + m * 16); float sq = 0.f;
#pragma unroll
                for (int bj = 0; bj < 2; ++bj) { const u32x4 w = xw[ai][m][bj];
                    const f32x4 x0 = (f32x4){__uint_as_float(w[0] << 16), __uint_as_float(w[0] & 0xffff0000u), __uint_as_float(w[1] << 16), __uint_as_float(w[1] & 0xffff0000u)};
                    const f32x4 x1 = (f32x4){__uint_as_float(w[2] << 16), __uint_as_float(w[2] & 0xffff0000u), __uint_as_float(w[3] << 16), __uint_as_float(w[3] & 0xffff0000u)};
                    acc[ai][bj][m][0] += x0; acc[ai][bj][m][1] += x1; sq += sq8(acc[ai][bj][m][0], acc[ai][bj][m][1]); }
                sq += __shfl_xor(sq, 16); sq += __shfl_xor(sq, 32);
                if (fq == 0) unsafeAtomicAdd(SS + row, sq); }
        asm volatile("s_waitcnt vmcnt(0)" ::: "memory");
        unsigned* c = cnt + 64 * u.pm;
        if (fr == 0 && fq == 0) (void)__hip_atomic_fetch_add(c, 1u, __ATOMIC_RELAXED, __HIP_MEMORY_SCOPE_AGENT);
        { unsigned sp = 0; while (__hip_atomic_load(c, __ATOMIC_RELAXED, __HIP_MEMORY_SCOPE_AGENT) < 32u) { __builtin_amdgcn_s_sleep(2); if (++sp > (1u << 22)) break; } }
        const f32x4 g00 = *(const f32x4*)(gain + col0), g01 = *(const f32x4*)(gain + col0 + 4), g10 = *(const f32x4*)(gain + col0 + 128), g11 = *(const f32x4*)(gain + col0 + 132);
        float ssv[8];
#pragma unroll
        for (int i = 0; i < 8; ++i) ssv[i] = __hip_atomic_load(SS + (size_t)(row0 + (i >> 2) * 128 + (i & 3) * 16), __ATOMIC_RELAXED, __HIP_MEMORY_SCOPE_AGENT);
#pragma unroll
        for (int ai = 0; ai < 2; ++ai)
#pragma unroll
            for (int m = 0; m < 4; ++m) { const size_t row = (size_t)(row0 + ai * 128 + m * 16), off = row * 1024 + col0;
                const float rs = __builtin_amdgcn_rsqf(ssv[ai * 4 + m] * (1.0f / 1024.0f) + EPS);
                *(f32x4*)(OUT + off) = acc[ai][0][m][0] * rs * g00; *(f32x4*)(OUT + off + 4) = acc[ai][0][m][1] * rs * g01;
                *(f32x4*)(OUT + off + 128) = acc[ai][1][m][0] * rs * g10; *(f32x4*)(OUT + off + 132) = acc[ai][1][m][1] * rs * g11; }
    }
};
struct SwiGLU {
    static constexpr bool PERM = true, AFTER_DRAIN = false;
    bf16* GU; const float* SS;
    DI void operator()(const f32x4 (&acc)[2][2][4][2], const Unit& u, int wr, int wc, int fr, int fq) const {
        const int row0 = u.pm * 256 + wr * 64 + fr, col0 = u.pn * 128 + wc * 32 + 8 * fq;
        float ssv[8];
#pragma unroll
        for (int i = 0; i < 8; ++i) ssv[i] = SS[(size_t)(row0 + (i >> 2) * 128 + (i & 3) * 16)];
#pragma unroll
        for (int ai = 0; ai < 2; ++ai)
#pragma unroll
            for (int m = 0; m < 4; ++m) {
                const size_t row = (size_t)(row0 + ai * 128 + m * 16);
                const float rs = __builtin_amdgcn_rsqf(ssv[ai * 4 + m] * (1.0f / 1024.0f) + EPS);
                const float c1 = -rs * 1.4426950408889634f, rs2 = rs * rs;
                f32x4 o[2];
#pragma unroll
                for (int n = 0; n < 2; ++n)
#pragma unroll
                    for (int j = 0; j < 4; ++j) { const float ga = acc[ai][0][m][n][j], ua = acc[ai][1][m][n][j];
                        o[n][j] = (ga * ua) * (rs2 * __builtin_amdgcn_rcpf(1.0f + __builtin_amdgcn_exp2f(ga * c1))); }
                __builtin_nontemporal_store(pack8(o[0], o[1]), (u32x4*)(GU + row * DFF + col0));
            }
    }
};
}

namespace att {
constexpr int NW = 8, QBLK = 32, KVBLK = 64;
constexpr float THR = 8.f;
constexpr int SHM_V = KVBLK * 128 * 2, SHM_K = KVBLK * 128 * 2, SHM_P = KVBLK * 64 * 2;
constexpr int OFF_V = 0, OFF_K = 2 * SHM_V, OFF_P = OFF_K + 2 * SHM_K, OFF_WS = OFF_P + 2 * SHM_P, OFF_QP = OFF_WS + NW * 64 * 4, LDS_BYTES = OFF_QP + NW * 4096;
#define KSWZ(row, colB) ((row) * 256 + ((colB) ^ (((row) & 7) << 4)))
#define PSWZ(row, colB) ((row) * 128 + ((colB) ^ ((((row) >> 1) & 7) << 4)))
#define SBAR() __builtin_amdgcn_sched_barrier(0)
DI int crow(int r, int hi) { return (r & 3) + 8 * (r >> 2) + 4 * hi; }
DI unsigned cvtpk(float lo, float hi) { unsigned r; asm volatile("v_cvt_pk_bf16_f32 %0, %1, %2" : "=v"(r) : "v"(lo), "v"(hi)); return r; }
DI unsigned short f2bf(float f) { unsigned u = __builtin_bit_cast(unsigned, f); return (unsigned short)((u + 0x7fffu + ((u >> 16) & 1u)) >> 16); }

template <int SC1000000>
struct Sc { static constexpr float SCALE = SC1000000 * 1e-6f; };

DI void partialSM(f32x16& p0, f32x16& p1, float& m_reg, float& mn, float& alpha, const float SCALE) {
  const float C = SCALE * 1.4426950408889634f;
  float pmax = p0[0];
#pragma unroll
  for (int r = 1; r < 16; ++r) pmax = fmaxf(pmax, p0[r]);
#pragma unroll
  for (int r = 0; r < 16; ++r) pmax = fmaxf(pmax, p1[r]);
  { auto rr = __builtin_amdgcn_permlane32_swap(__float_as_uint(pmax), __float_as_uint(pmax), false, false);
    pmax = fmaxf(__uint_as_float(rr[0]), __uint_as_float(rr[1])); }
  if (__builtin_expect(__all(pmax - m_reg <= THR / SCALE), 1)) { mn = m_reg; alpha = 1.f; }
  else { mn = fmaxf(m_reg, pmax); alpha = __builtin_amdgcn_exp2f((m_reg - mn) * C); m_reg = mn; }
  float mnC = -mn * C;
#pragma unroll
  for (int r = 0; r < 16; ++r) p0[r] = fmaf(p0[r], C, mnC);
#pragma unroll
  for (int r = 0; r < 16; ++r) p1[r] = fmaf(p1[r], C, mnC);
#pragma unroll
  for (int r = 0; r < 16; ++r) p0[r] = __builtin_amdgcn_exp2f(p0[r]);
}
#define PK4(P, BASE, OUT) do { unsigned a0 = cvtpk(P[BASE + 0], P[BASE + 1]), a1 = cvtpk(P[BASE + 2], P[BASE + 3]);   \
    unsigned b0 = cvtpk(P[BASE + 4], P[BASE + 5]), b1 = cvtpk(P[BASE + 6], P[BASE + 7]);                              \
    auto r0 = __builtin_amdgcn_permlane32_swap(a0, b0, false, false); auto r1 = __builtin_amdgcn_permlane32_swap(a1, b1, false, false); \
    u32x4 w = {r0[0], r1[0], r0[1], r1[1]}; OUT = *reinterpret_cast<bf16x8*>(&w); } while (0)
DI void finishSM(f32x16& p0, f32x16& p1, float alpha, float& l_reg, bf16x8& pa0, bf16x8& pa1, bf16x8& pa2, bf16x8& pa3) {
#pragma unroll
  for (int r = 0; r < 16; ++r) p1[r] = __builtin_amdgcn_exp2f(p1[r]);
  float ps = 0;
#pragma unroll
  for (int r = 0; r < 16; ++r) ps += p0[r];
#pragma unroll
  for (int r = 0; r < 16; ++r) ps += p1[r];
  { auto rr = __builtin_amdgcn_permlane32_swap(__float_as_uint(ps), __float_as_uint(ps), false, false);
    ps = __uint_as_float(rr[0]) + __uint_as_float(rr[1]); }
  l_reg = l_reg * alpha + ps;
  PK4(p0, 0, pa0); PK4(p0, 8, pa1); PK4(p1, 0, pa2); PK4(p1, 8, pa3);
}
template <int NPE>
DI void qkt(f32x16& p0, f32x16& p1, const char* Ks, const char* Ps, const bf16x8* qr, const char* Qp, int r32, int hi) {
  p0 = f32x16{}; p1 = f32x16{};
#pragma unroll
  for (int d0 = 0; d0 < 8; ++d0) { int cb = (d0 * 16 + hi * 8) * 2;
    bf16x8 b0 = *reinterpret_cast<const bf16x8*>(Ks + KSWZ(r32, cb));
    bf16x8 b1 = *reinterpret_cast<const bf16x8*>(Ks + KSWZ(32 + r32, cb));
    p0 = __builtin_amdgcn_mfma_f32_32x32x16_bf16(b0, qr[d0], p0, 0, 0, 0);
    p1 = __builtin_amdgcn_mfma_f32_32x32x16_bf16(b1, qr[d0], p1, 0, 0, 0); }
#pragma unroll
  for (int d0 = 0; d0 < NPE; ++d0) { int cb = (d0 * 16 + hi * 8) * 2;
    bf16x8 b0 = *reinterpret_cast<const bf16x8*>(Ps + PSWZ(r32, cb));
    bf16x8 b1 = *reinterpret_cast<const bf16x8*>(Ps + PSWZ(32 + r32, cb));
    const bf16x8 qq = *reinterpret_cast<const bf16x8*>(Qp + PSWZ(r32, cb));
    p0 = __builtin_amdgcn_mfma_f32_32x32x16_bf16(b0, qq, p0, 0, 0, 0);
    p1 = __builtin_amdgcn_mfma_f32_32x32x16_bf16(b1, qq, p1, 0, 0, 0); }
}
DI int v_st(int k, int c) { const int kk = (k & ~0xC) | ((k & 4) << 1) | ((k & 8) >> 1); return ((kk >> 3) * 4 + (c >> 5)) * 512 + ((kk & 7) * 32 + (c & 31)) * 2; }
DI int v_rd_base(int lane) { return ((lane & 3) << 3) | (((lane >> 2) & 3) << 6) | (((lane >> 4) & 1) << 5) | (((lane >> 5) & 1) << 8); }
constexpr int v_rd_off(int d0, int ks, int half) { return d0 * 512 + ks * 4096 + half * 2048; }
template <int OFF> DI s16x4 tr_read(int vb) {
  s16x4 r; asm volatile("ds_read_b64_tr_b16 %0, %1 offset:%2" : "=&v"(r) : "v"(vb), "i"(OFF) : "memory"); return r;
}
template <int D0, bool SPLIT> DI void pv_one(f32x16& od, int vb, bf16x8 pa0, bf16x8 pa1, bf16x8 pa2, bf16x8 pa3) {
#define PKV(L, H) (bf16x8){L[0], L[1], L[2], L[3], H[0], H[1], H[2], H[3]}
  if constexpr (SPLIT) {
    { const s16x4 l0 = tr_read<v_rd_off(D0, 0, 0)>(vb), h0 = tr_read<v_rd_off(D0, 0, 1)>(vb), l1 = tr_read<v_rd_off(D0, 1, 0)>(vb), h1 = tr_read<v_rd_off(D0, 1, 1)>(vb);
      asm volatile("s_waitcnt lgkmcnt(0)" ::: "memory"); SBAR();
      od = __builtin_amdgcn_mfma_f32_32x32x16_bf16(PKV(l0, h0), pa0, od, 0, 0, 0);
      od = __builtin_amdgcn_mfma_f32_32x32x16_bf16(PKV(l1, h1), pa1, od, 0, 0, 0); }
    SBAR();
    { const s16x4 l2 = tr_read<v_rd_off(D0, 2, 0)>(vb), h2 = tr_read<v_rd_off(D0, 2, 1)>(vb), l3 = tr_read<v_rd_off(D0, 3, 0)>(vb), h3 = tr_read<v_rd_off(D0, 3, 1)>(vb);
      asm volatile("s_waitcnt lgkmcnt(0)" ::: "memory"); SBAR();
      od = __builtin_amdgcn_mfma_f32_32x32x16_bf16(PKV(l2, h2), pa2, od, 0, 0, 0);
      od = __builtin_amdgcn_mfma_f32_32x32x16_bf16(PKV(l3, h3), pa3, od, 0, 0, 0); }
    SBAR();
  } else {
  const s16x4 l0 = tr_read<v_rd_off(D0, 0, 0)>(vb), h0 = tr_read<v_rd_off(D0, 0, 1)>(vb), l1 = tr_read<v_rd_off(D0, 1, 0)>(vb), h1 = tr_read<v_rd_off(D0, 1, 1)>(vb);
  const s16x4 l2 = tr_read<v_rd_off(D0, 2, 0)>(vb), h2 = tr_read<v_rd_off(D0, 2, 1)>(vb), l3 = tr_read<v_rd_off(D0, 3, 0)>(vb), h3 = tr_read<v_rd_off(D0, 3, 1)>(vb);
  asm volatile("s_waitcnt lgkmcnt(0)" ::: "memory"); SBAR();
  od = __builtin_amdgcn_mfma_f32_32x32x16_bf16(PKV(l0, h0), pa0, od, 0, 0, 0);
  od = __builtin_amdgcn_mfma_f32_32x32x16_bf16(PKV(l1, h1), pa1, od, 0, 0, 0);
  od = __builtin_amdgcn_mfma_f32_32x32x16_bf16(PKV(l2, h2), pa2, od, 0, 0, 0);
  od = __builtin_amdgcn_mfma_f32_32x32x16_bf16(PKV(l3, h3), pa3, od, 0, 0, 0);
  }
}
template <bool SPLIT>
DI void pv_d0(f32x16* o, int vb, bf16x8 pa0, bf16x8 pa1, bf16x8 pa2, bf16x8 pa3) {
  pv_one<0, SPLIT>(o[0], vb, pa0, pa1, pa2, pa3); pv_one<1, SPLIT>(o[1], vb, pa0, pa1, pa2, pa3); pv_one<2, SPLIT>(o[2], vb, pa0, pa1, pa2, pa3); pv_one<3, SPLIT>(o[3], vb, pa0, pa1, pa2, pa3);
}
constexpr int R_STG = 40960, R_V = 0, R_K = 16384, R_P = 32768, R_WS = 3 * R_STG, RING_LDS_BYTES = R_WS + NW * 64 * 4;
template <int NPE>
DI void qkt_r(f32x16& p0, f32x16& p1, const char* Ks, const char* Ps, const bf16x8* qr, int r32, int hi) {
  p0 = f32x16{}; p1 = f32x16{};
#pragma unroll
  for (int d0 = 0; d0 < 8; ++d0) { int cb = (d0 * 16 + hi * 8) * 2;
    bf16x8 b0 = *reinterpret_cast<const bf16x8*>(Ks + KSWZ(r32, cb));
    bf16x8 b1 = *reinterpret_cast<const bf16x8*>(Ks + KSWZ(32 + r32, cb));
    p0 = __builtin_amdgcn_mfma_f32_32x32x16_bf16(b0, qr[d0], p0, 0, 0, 0);
    p1 = __builtin_amdgcn_mfma_f32_32x32x16_bf16(b1, qr[d0], p1, 0, 0, 0); }
#pragma unroll
  for (int d0 = 0; d0 < NPE; ++d0) { int cb = (d0 * 16 + hi * 8) * 2;
    bf16x8 b0 = *reinterpret_cast<const bf16x8*>(Ps + PSWZ(r32, cb));
    bf16x8 b1 = *reinterpret_cast<const bf16x8*>(Ps + PSWZ(32 + r32, cb));
    p0 = __builtin_amdgcn_mfma_f32_32x32x16_bf16(b0, qr[8 + d0], p0, 0, 0, 0);
    p1 = __builtin_amdgcn_mfma_f32_32x32x16_bf16(b1, qr[8 + d0], p1, 0, 0, 0); }
}
template <int NPE, int LDQ, int LDK, int VOFF, int LDO>
DI void dense_ring(const bf16* __restrict__ Qb, const bf16* __restrict__ Kh, const bf16* __restrict__ Ph, const float* __restrict__ TCq, const float* __restrict__ TSq,
                   bf16* __restrict__ Ob, int seq, const float SCALE, char* lds) {
  const int tid = opaque_tid(), wid = tid >> 6, lane = tid & 63, r32 = lane & 31, hi = lane >> 5;
  unsigned vof[2], kof[2], pof;
#pragma unroll
  for (int j = 0; j < 2; ++j) { const int sp = 2 * wid + j;
    { const int st = 2 * sp + (lane >> 5), kk = (st >> 2) * 8 + ((lane & 31) >> 2), k = (kk & ~0xC) | ((kk & 4) << 1) | ((kk & 8) >> 1), c = (st & 3) * 32 + (lane & 3) * 8;
      vof[j] = (unsigned)(k * LDK + VOFF + c) * 2u; }
    { const int row = 4 * sp + (lane >> 4), ch = (lane & 15) ^ (row & 7); kof[j] = (unsigned)(row * LDK + ch * 8) * 2u; } }
  { const int row = 8 * wid + (lane >> 3), ch = (lane & 7) ^ ((row >> 1) & 7); pof = (unsigned)(row * 64 + ch * 8) * 2u; }
#define ISSUE(k0, stg) do { const char* kb_ = (const char*)(Kh + (size_t)(k0) * LDK); char* sg_ = (stg); \
    _Pragma("unroll") for (int j_ = 0; j_ < 2; ++j_) { \
      __builtin_amdgcn_global_load_lds((const unsigned*)(kb_ + vof[j_]), (LAS unsigned*)(uintptr_t)(sg_ + R_V + (2 * wid + j_) * 1024), 16, 0, 0); \
      __builtin_amdgcn_global_load_lds((const unsigned*)(kb_ + kof[j_]), (LAS unsigned*)(uintptr_t)(sg_ + R_K + (2 * wid + j_) * 1024), 16, 0, 0); } \
    if constexpr (NPE > 0) __builtin_amdgcn_global_load_lds((const unsigned*)((const char*)(Ph + (size_t)(k0) * 64) + pof), (LAS unsigned*)(uintptr_t)(sg_ + R_P + wid * 1024), 16, 0, 0); } while (0)
#define RBAR() do { asm volatile("s_waitcnt vmcnt(0) lgkmcnt(0)" ::: "memory"); __builtin_amdgcn_s_barrier(); asm volatile("" ::: "memory"); } while (0)
  char* s_prev = lds; char* s_cur = lds + R_STG; char* s_next = lds + 2 * R_STG;
  ISSUE(0, s_prev); ISSUE(KVBLK, s_cur);
  float m_reg = -1e30f, l_reg = 0; f32x16 o[4] = {}; bf16x8 qr[8 + NPE];
  const bf16* Qw = (const bf16*)((const char*)Qb + (unsigned)((wid * QBLK + r32) * LDQ + hi * 8) * 2u);
#pragma unroll
  for (int d0 = 0; d0 < 8; ++d0) qr[d0] = *reinterpret_cast<const bf16x8*>(Qw + d0 * 16);
  if constexpr (NPE > 0) {
    const unsigned tqo = (unsigned)((wid * QBLK + r32) * 32 + hi * 8) * 4u;
#pragma unroll
    for (int d0 = 0; d0 < 2; ++d0) {
      const u32x4 x1 = *reinterpret_cast<const u32x4*>(Qw + 128 + d0 * 16), x2 = *reinterpret_cast<const u32x4*>(Qw + 160 + d0 * 16);
      const f32x4 cA = *(const f32x4*)((const char*)TCq + tqo + d0 * 64), cB = *(const f32x4*)((const char*)TCq + tqo + d0 * 64 + 16);
      const f32x4 sA = *(const f32x4*)((const char*)TSq + tqo + d0 * 64), sB = *(const f32x4*)((const char*)TSq + tqo + d0 * 64 + 16);
      u32x4 y1, y2;
#pragma unroll
      for (int e = 0; e < 4; ++e) {
        const float a0 = __uint_as_float(x1[e] << 16), a1 = __uint_as_float(x1[e] & 0xffff0000u), b0 = __uint_as_float(x2[e] << 16), b1 = __uint_as_float(x2[e] & 0xffff0000u);
        const float c0 = (e < 2) ? cA[2 * e] : cB[2 * e - 4], c1 = (e < 2) ? cA[2 * e + 1] : cB[2 * e - 3], s0 = (e < 2) ? sA[2 * e] : sB[2 * e - 4], s1 = (e < 2) ? sA[2 * e + 1] : sB[2 * e - 3];
        y1[e] = cvtpk(a0 * c0 - b0 * s0, a1 * c1 - b1 * s1); y2[e] = cvtpk(b0 * c0 + a0 * s0, b1 * c1 + a1 * s1); }
      qr[8 + d0] = *reinterpret_cast<bf16x8*>(&y1); qr[8 + d0 + 2] = *reinterpret_cast<bf16x8*>(&y2);
    }
  }
#define RESC(a) do { if (__any((a) < 1.f)) { _Pragma("unroll") for (int d = 0; d < 4; ++d) o[d] *= (a); } } while (0)
  f32x16 pA0, pA1, pB0, pB1; float mnA, mnB, alA, alB; bf16x8 pa0, pa1, pa2, pa3; const int NT = seq / KVBLK;
  const int vlane = v_rd_base(lane);
  RBAR();
  ISSUE(2 * KVBLK, s_next);
  qkt_r<NPE>(pA0, pA1, s_prev + R_K, s_prev + R_P, qr, r32, hi); partialSM(pA0, pA1, m_reg, mnA, alA, SCALE);
#define RTILE(PC0, PC1, PP0, PP1, mnC, alC, alP, jt) do { \
    SBAR(); qkt_r<NPE>(PC0, PC1, s_cur + R_K, s_cur + R_P, qr, r32, hi); \
    finishSM(PP0, PP1, alP, l_reg, pa0, pa1, pa2, pa3); SBAR(); \
    pv_d0<false>(o, (int)(uintptr_t)(s_prev + R_V) + vlane, pa0, pa1, pa2, pa3); partialSM(PC0, PC1, m_reg, mnC, alC, SCALE); \
    RESC(alC); \
    RBAR(); \
    if ((jt) + 2 < NT) ISSUE(((jt) + 2) * KVBLK, s_prev); \
    { char* t_ = s_prev; s_prev = s_cur; s_cur = s_next; s_next = t_; } } while (0)
  for (int j = 1; j + 1 < NT; j += 2) {
    RTILE(pB0, pB1, pA0, pA1, mnB, alB, alA, j);
    RTILE(pA0, pA1, pB0, pB1, mnA, alA, alB, j + 1);
  }
  RTILE(pB0, pB1, pA0, pA1, mnB, alB, alA, NT - 1);
  finishSM(pB0, pB1, alB, l_reg, pa0, pa1, pa2, pa3); SBAR();
  pv_d0<false>(o, (int)(uintptr_t)(s_prev + R_V) + vlane, pa0, pa1, pa2, pa3);
  { const float rl = __builtin_amdgcn_rcpf(l_reg);
    bf16* Ow = Ob + (long)(wid * QBLK + r32) * LDO + 8 * hi;
#pragma unroll
    for (int d0 = 0; d0 < 4; ++d0) { o[d0] *= rl; bf16x8 w0, w1; PK4(o[d0], 0, w0); PK4(o[d0], 8, w1);
      *(bf16x8*)(Ow + d0 * 32) = w0; *(bf16x8*)(Ow + d0 * 32 + 16) = w1; } }
  RBAR();
#undef ISSUE
#undef RBAR
#undef RESC
#undef RTILE
}
}

namespace dil {
using att::crow; using att::cvtpk; using att::f2bf;
constexpr int OFF_K = 0, OFF_V = 49152, OFF_POS = 98304, OFF_WS = OFF_POS + 2048, LDS_BYTES = OFF_WS + 8 * 64 * 4;
typedef short v4i16_t __attribute__((ext_vector_type(4)));
DI int v_st64(int k, int c) { const int kk = (k & ~0xC) | ((k & 4) << 1) | ((k & 8) >> 1); return ((kk >> 3) * 2 + (c >> 5)) * 512 + ((kk & 7) * 32 + (c & 31)) * 2; }
DI s16x4 vtr(const char* p) { return __builtin_bit_cast(s16x4, __builtin_amdgcn_ds_read_tr16_b64_v4i16((LAS v4i16_t*)(uintptr_t)p)); }

DI void unit(const bf16* __restrict__ QKV, const int* __restrict__ pos, bf16* __restrict__ OA, float* __restrict__ LSE,
             int b, int h, int d, int r, int qb, float slope, char* lds) {
  const int tid = opaque_tid(), wid = tid >> 6, lane = tid & 63, r32 = lane & 31, hi = lane >> 5;
  const int L = SEQ / d, u0 = qb * 256;
  char* K_lds = lds + OFF_K; char* V_lds = lds + OFF_V; int* posk = (int*)(lds + OFF_POS); float* ws = (float*)(lds + OFF_WS) + wid * 64;
  const bf16* base = QKV + (size_t)(b * 8 + h) * SEQ * 64;
  constexpr size_t PLANE = (size_t)NB * 8 * SEQ * 64 * 2;
  auto stage = [&](const int i0) {
    bf16x8 kreg[3], vreg[3];
#pragma unroll
    for (int i = 0; i < 3; ++i) { const int idx = tid + (i0 + i) * 512, row = idx >> 3, ch = idx & 7, v = u0 - 64 + row; const bool ok = (v >= 0) && (v < L);
      const unsigned go = (unsigned)((r + d * (ok ? v : 0)) * 64 + ch * 8) * 2u;
      kreg[i] = *(const bf16x8*)((const char*)base + PLANE + go); vreg[i] = *(const bf16x8*)((const char*)base + 2 * PLANE + go);
      if (!ok) { kreg[i] = bf16x8{}; vreg[i] = bf16x8{}; } }
#pragma unroll
    for (int i = 0; i < 3; ++i) { const int idx = tid + (i0 + i) * 512, row = idx >> 3, ch = idx & 7;
      *(bf16x8*)(K_lds + PSWZ(row, ch * 16)) = kreg[i]; *(bf16x8*)(V_lds + v_st64(row, ch * 8)) = vreg[i]; }
  };
  stage(0); SBAR(); stage(3); SBAR();
  float pkv = 3.0e8f; if (tid < 384) { const int v = u0 - 64 + tid; if (v >= 0 && v < L) pkv = (float)pos[b * SEQ + r + d * v]; }
  const int uq = u0 + wid * 32 + r32, tq = r + d * uq;
  bf16x8 qr[4];
#pragma unroll
  for (int d0 = 0; d0 < 4; ++d0) qr[d0] = *(const bf16x8*)((const char*)base + (unsigned)(tq * 64 + d0 * 16 + hi * 8) * 2u);
  const int pq = pos[b * SEQ + tq];
  if (tid < 384) ((float*)posk)[tid] = pkv;
  __syncthreads();
  f32x16 p[5];
#pragma unroll
  for (int ta = 0; ta < 5; ++ta) { p[ta] = f32x16{};
#pragma unroll
    for (int d0 = 0; d0 < 4; ++d0) { const bf16x8 a = *(const bf16x8*)(K_lds + PSWZ(wid * 32 + ta * 32 + r32, (d0 * 16 + hi * 8) * 2));
      p[ta] = __builtin_amdgcn_mfma_f32_32x32x16_bf16(a, qr[d0], p[ta], 0, 0, 0); }
    SBAR(); }
  const float C = 0.125f * 1.4426950408889634f, sl2 = slope * 1.4426950408889634f;
  const float* pbase = (const float*)posk + wid * 32 + 4 * hi; const float pqf = (float)pq;
  float mx = -1e30f;
#pragma unroll
  for (int ta = 0; ta < 5; ++ta) {
#pragma unroll
    for (int g = 0; g < 4; ++g) { const f32x4 pk4 = *(const f32x4*)(pbase + ta * 32 + 8 * g);
#pragma unroll
      for (int j = 0; j < 4; ++j) { const int rr = 4 * g + j, kr = j + 8 * g + 4 * hi;
        float sc = fmaf(__builtin_fabsf(pqf - pk4[j]), -sl2, p[ta][rr] * C);
        if (ta == 0) sc = (kr >= r32) ? sc : -1e30f;
        if (ta == 4) sc = (kr <= r32) ? sc : -1e30f;
        p[ta][rr] = sc; mx = fmaxf(mx, sc); } }
    SBAR(); }
  { auto x = __builtin_amdgcn_permlane32_swap(__float_as_uint(mx), __float_as_uint(mx), false, false); mx = fmaxf(__uint_as_float(x[0]), __uint_as_float(x[1])); }
  float ls = 0.f;
#pragma unroll
  for (int ta = 0; ta < 5; ++ta)
#pragma unroll
    for (int rr = 0; rr < 16; ++rr) { p[ta][rr] = __builtin_amdgcn_exp2f(p[ta][rr] - mx); ls += p[ta][rr]; if (rr == 15) SBAR(); }
  { auto x = __builtin_amdgcn_permlane32_swap(__float_as_uint(ls), __float_as_uint(ls), false, false); ls = __uint_as_float(x[0]) + __uint_as_float(x[1]); }
  f32x16 o[2] = {};
  const char* vb = V_lds + att::v_rd_base(lane) + wid * 2 * 2048;
#pragma unroll
  for (int ta = 0; ta < 5; ++ta) {
    bf16x8 pa0, pa1; PK4(p[ta], 0, pa0); PK4(p[ta], 8, pa1);
#pragma unroll
    for (int d0 = 0; d0 < 2; ++d0) {
      const s16x4 l0 = vtr(vb + (2 * ta) * 2048 + d0 * 512), h0 = vtr(vb + (2 * ta) * 2048 + 1024 + d0 * 512);
      const s16x4 l1 = vtr(vb + (2 * ta + 1) * 2048 + d0 * 512), h1 = vtr(vb + (2 * ta + 1) * 2048 + 1024 + d0 * 512);
      o[d0] = __builtin_amdgcn_mfma_f32_32x32x16_bf16((bf16x8){l0[0], l0[1], l0[2], l0[3], h0[0], h0[1], h0[2], h0[3]}, pa0, o[d0], 0, 0, 0);
      o[d0] = __builtin_amdgcn_mfma_f32_32x32x16_bf16((bf16x8){l1[0], l1[1], l1[2], l1[3], h1[0], h1[1], h1[2], h1[3]}, pa1, o[d0], 0, 0, 0);
    }
    SBAR();
  }
  if (hi == 0) LSE[(size_t)(b * SEQ + tq) * 8 + h] = (mx + __builtin_amdgcn_logf(ls)) * 0.6931471805599453f;
  { const float rl = __builtin_amdgcn_rcpf(ls); bf16* orow = OA + (size_t)(b * SEQ + tq) * 512 + h * 64 + 8 * hi;
#pragma unroll
    for (int d0 = 0; d0 < 2; ++d0) { o[d0] *= rl; bf16x8 w0, w1; PK4(o[d0], 0, w0); PK4(o[d0], 8, w1);
      *(bf16x8*)(orow + d0 * 32) = w0; *(bf16x8*)(orow + d0 * 32 + 16) = w1; } }
  __syncthreads();
}
}

#define XB_TMO      128
#define XB_XCNT(j)  (256  + 64 * (j))
#define XB_XSUB(j)  (1280 + 64 * (j))
#define XB_XGEN(j)  (2304 + 64 * (j))
#define XB_TOP      3328
#define XB_TOPGEN   3392
#define XCD_BAR_WORDS 3456
#define XB_SPIN_CAP (1u << 18)

__device__ __forceinline__ unsigned xb_ld(unsigned* p)              { return __hip_atomic_load(p, __ATOMIC_RELAXED, __HIP_MEMORY_SCOPE_AGENT); }
__device__ __forceinline__ unsigned xb_add(unsigned* p, unsigned v) { return __hip_atomic_fetch_add(p, v, __ATOMIC_RELAXED, __HIP_MEMORY_SCOPE_AGENT); }
__device__ __forceinline__ unsigned xb_xcc_id() { return (unsigned)__builtin_amdgcn_s_getreg((3 << 11) | 20) & 0xFu; }
#define XB_SPIN(cond, bar) do { unsigned _sp = 0; while (cond) { __builtin_amdgcn_s_sleep(1); \
    if ((++_sp & 255u) == 0u) { if (xb_ld(&(bar)[XB_TMO])) break; if (_sp > XB_SPIN_CAP) { atomicAdd(&(bar)[XB_TMO], 1u); break; } } } } while (0)

struct XcdBarrier {
    unsigned* bar; unsigned x;
    volatile LAS unsigned* st;
};

__device__ __forceinline__ XcdBarrier xcd_barrier_post(unsigned* bar, volatile LAS unsigned* st) {
    XcdBarrier b; b.bar = bar; b.x = xb_xcc_id(); b.st = st;
    if (threadIdx.x == 0) (void)xb_add(&bar[XB_XCNT(b.x)], 1u);
    return b;
}
__device__ __forceinline__ void xcd_barrier_complete(unsigned* bar, unsigned x, unsigned& nloc, unsigned& nx) {
    const unsigned G = gridDim.x * gridDim.y * gridDim.z;
    unsigned sum, cnt, mine, sp = 0u;
    for (;;) {
        sum = 0u; cnt = 0u; mine = 0u;
#pragma unroll
        for (unsigned j = 0; j < 16; ++j) { const unsigned c = xb_ld(&bar[XB_XCNT(j)]); sum += c; cnt += (c > 0u) ? 1u : 0u; mine = (j == x) ? c : mine; }
        if (sum == G) break;
        __builtin_amdgcn_s_sleep(1);
        if ((++sp & 255u) == 0u) { if (xb_ld(&bar[XB_TMO])) break; if (sp > XB_SPIN_CAP) { atomicAdd(&bar[XB_TMO], 1u); break; } }
    }
    nloc = mine > 0u ? mine : 1u; nx = cnt > 0u ? cnt : 1u;
}

__device__ __forceinline__ void xcd_barrier(const XcdBarrier& b) {
    asm volatile("s_waitcnt vmcnt(0)" ::: "memory");
    __syncthreads();
    if (threadIdx.x == 0) {
        unsigned* bar = b.bar;
        __builtin_amdgcn_s_waitcnt(0);
        unsigned nloc = b.st[0], nx = b.st[1];
        if (nloc == 0u) { xcd_barrier_complete(bar, b.x, nloc, nx); b.st[0] = nloc; b.st[1] = nx; }
        const unsigned old = xb_add(&bar[XB_XSUB(b.x)], 1u);
        const unsigned gen = old / nloc;
        if (old + 1u == (gen + 1u) * nloc) {
            __builtin_amdgcn_fence(__ATOMIC_RELEASE, "agent");
            asm volatile("s_waitcnt vmcnt(0)" ::: "memory");
            const unsigned og = xb_add(&bar[XB_TOP], 1u);
            const unsigned tg = og / nx;
            if (og + 1u == (tg + 1u) * nx) xb_add(&bar[XB_TOPGEN], 1u);
            else XB_SPIN(xb_ld(&bar[XB_TOPGEN]) == tg, bar);
            __builtin_amdgcn_fence(__ATOMIC_ACQUIRE, "agent");
            xb_add(&bar[XB_XGEN(b.x)], 1u);
            asm volatile("s_waitcnt vmcnt(0)" ::: "memory");
        } else {
            XB_SPIN(xb_ld(&bar[XB_XGEN(b.x)]) == gen, bar);
            __builtin_amdgcn_fence(__ATOMIC_ACQUIRE, "agent");
            asm volatile("s_waitcnt vmcnt(0)" ::: "memory");
        }
    }
    __syncthreads();
}

constexpr size_t MiB = 1u << 20;
constexpr size_t WS_WIN = 0, WS_WMKV = WS_WIN + (size_t)DIN_PAD * 1024 * 2, WS_WQ = WS_WMKV + 2 * MiB, WS_WKV = WS_WQ + (size_t)768 * 384 * 2, WS_WOUT = WS_WKV + (size_t)1024 * 256 * 2,
                 WS_WMQ = WS_WOUT + 2 * MiB, WS_WMO = WS_WMQ + 1 * MiB, WS_WGU = WS_WMO + 1 * MiB, WS_WDN = WS_WGU + 11 * MiB, WS_WEND = WS_WDN + (size_t)1024 * DFF * 2;
static_assert(WS_WEND <= 32 * MiB, "weights");
constexpr size_t WS_CTL = 31 * MiB, CTL_BYTES = 16384, WS_PCNT = WS_CTL + CTL_BYTES;
static_assert(WS_WEND <= WS_CTL && XCD_BAR_WORDS * 4 <= CTL_BYTES, "ctl");
constexpr size_t WS_HB = 32 * MiB, WS_MK = 96 * MiB, WS_MKV = 100 * MiB, WS_TC = 104 * MiB, WS_TS = 108 * MiB, WS_KPE = 112 * MiB, WS_LSE = 116 * MiB, WS_SSQ = 120 * MiB,
                 WS_OB = 124 * MiB, WS_OA = 156 * MiB, WS_R = 252 * MiB;
constexpr size_t WS_QKV = WS_R, WS_KVB = WS_R + 96 * MiB, WS_QB = WS_KVB + 64 * MiB, WS_CQ = WS_QB + 48 * MiB, WS_CKV = WS_CQ + 24 * MiB, WS_SS3F = WS_CKV + 16 * MiB, WS_RS2 = WS_SS3F + 2 * MiB, WS_END = WS_RS2 + 1 * MiB;
constexpr size_t WS_MQ = WS_R, WS_MO = WS_R + 32 * MiB, WS_GU = WS_R;
constexpr size_t WS_XB1 = WS_OA, WS_XB2 = WS_HB, WS_X3 = WS_OA, WS_SS1 = WS_LSE, WS_SS2 = WS_LSE + 2 * MiB, WS_SS3 = WS_SSQ;
static_assert(WS_END <= 512 * MiB && WS_GU + (size_t)T * DFF * 2 <= WS_END, "workspace map");
constexpr int MISC_OFF = 131072 + 2048;
constexpr int LDS_BYTES = 135168;
static_assert(att::RING_LDS_BYTES <= MISC_OFF && att::LDS_BYTES <= MISC_OFF && dil::LDS_BYTES <= MISC_OFF && pg8::STAGE_BYTES <= MISC_OFF && MISC_OFF + 64 <= LDS_BYTES, "LDS");

struct Params {
    const float *x, *mem; const int* pos;
    const float *norm_mix, *w_in, *q_norm, *w_q_up, *kv_norm, *w_kv_up, *gout_a, *gout_b, *w_out, *norm_mem_q, *norm_mem_kv, *w_mq, *w_mkv, *w_mo, *norm_ffn, *w_gate, *w_up, *w_down, *norm_final;
    float* out; unsigned char* ws;
};

DI float wave_sum(float v) {
#pragma unroll
    for (int o = 1; o < 64; o <<= 1) v += __shfl_xor(v, o);
    return v;
}
DI unsigned pk2(float lo, float hi) { return pg8::cvt_pk_bf16(lo, hi); }

DI void transpose_item(const float* W, int ldn, int sc, const float* gain, bf16* WT, int K, int drow, int k0, LAS float* scr, int lane) {
    float tv[32];
#pragma unroll
    for (int i = 0; i < 32; ++i) { const int kk = 2 * i + (lane >> 5); tv[i] = 0.f;
        if (sc >= 0) { tv[i] = W[(size_t)(k0 + kk) * ldn + sc + (lane & 31)]; if (gain) tv[i] *= gain[k0 + kk]; } }
#pragma unroll
    for (int i = 0; i < 32; ++i) scr[(2 * i + (lane >> 5)) * 33 + (lane & 31)] = tv[i];
    asm volatile("s_waitcnt lgkmcnt(0)" ::: "memory");
    const int c = lane & 7;
#pragma unroll
    for (int j = 0; j < 4; ++j) { const int n = (lane >> 3) + 8 * j; const LAS float* s = scr + (8 * c) * 33 + n;
        u32x4 o; o.x = pk2(s[0 * 33], s[1 * 33]); o.y = pk2(s[2 * 33], s[3 * 33]); o.z = pk2(s[4 * 33], s[5 * 33]); o.w = pk2(s[6 * 33], s[7 * 33]);
        *(u32x4*)(WT + (size_t)(drow + n) * K + k0 + 8 * c) = o; }
    asm volatile("s_waitcnt lgkmcnt(0)" ::: "memory");
}
DI void norm_row_bf16(const float* xrow, const float* g, bf16* orow, int lane) {
    f32x4 v[4]; float s = 0.f;
#pragma unroll
    for (int j = 0; j < 4; ++j) { v[j] = *(const f32x4*)(xrow + 256 * j + 4 * lane); s += (v[j][0] * v[j][0] + v[j][1] * v[j][1]) + (v[j][2] * v[j][2] + v[j][3] * v[j][3]); }
    const float rs = __builtin_amdgcn_rsqf(wave_sum(s) * (1.f / 1024.f) + EPS);
#pragma unroll
    for (int j = 0; j < 4; ++j) { const f32x4 gg = *(const f32x4*)(g + 256 * j + 4 * lane);
        u32x2 o; o.x = pk2(v[j][0] * rs * gg[0], v[j][1] * rs * gg[1]); o.y = pk2(v[j][2] * rs * gg[2], v[j][3] * rs * gg[3]);
        *(u32x2*)(orow + 256 * j + 4 * lane) = o; }
}
DI void norm_row2_bf16(const float* xa, const float* xb, const float* g, bf16* oa, bf16* ob, int lane) {
    f32x4 va[4], vb[4]; float sa = 0.f, sb = 0.f;
#pragma unroll
    for (int j = 0; j < 4; ++j) { va[j] = *(const f32x4*)(xa + 256 * j + 4 * lane); vb[j] = *(const f32x4*)(xb + 256 * j + 4 * lane); }
#pragma unroll
    for (int j = 0; j < 4; ++j) { sa += (va[j][0] * va[j][0] + va[j][1] * va[j][1]) + (va[j][2] * va[j][2] + va[j][3] * va[j][3]); sb += (vb[j][0] * vb[j][0] + vb[j][1] * vb[j][1]) + (vb[j][2] * vb[j][2] + vb[j][3] * vb[j][3]); }
    const float ra = __builtin_amdgcn_rsqf(wave_sum(sa) * (1.f / 1024.f) + EPS), rb = __builtin_amdgcn_rsqf(wave_sum(sb) * (1.f / 1024.f) + EPS);
#pragma unroll
    for (int j = 0; j < 4; ++j) { const f32x4 gg = *(const f32x4*)(g + 256 * j + 4 * lane);
        u32x2 o; o.x = pk2(va[j][0] * ra * gg[0], va[j][1] * ra * gg[1]); o.y = pk2(va[j][2] * ra * gg[2], va[j][3] * ra * gg[3]); *(u32x2*)(oa + 256 * j + 4 * lane) = o;
        u32x2 p; p.x = pk2(vb[j][0] * rb * gg[0], vb[j][1] * rb * gg[1]); p.y = pk2(vb[j][2] * rb * gg[2], vb[j][3] * rb * gg[3]); *(u32x2*)(ob + 256 * j + 4 * lane) = p; }
}
DI void norm_row_f32(float* xrow, const float* g, int lane) {
    f32x4 v[4]; float s = 0.f;
#pragma unroll
    for (int j = 0; j < 4; ++j) { v[j] = *(const f32x4*)(xrow + 256 * j + 4 * lane); s += (v[j][0] * v[j][0] + v[j][1] * v[j][1]) + (v[j][2] * v[j][2] + v[j][3] * v[j][3]); }
    const float rs = __builtin_amdgcn_rsqf(wave_sum(s) * (1.f / 1024.f) + EPS);
#pragma unroll
    for (int j = 0; j < 4; ++j) { const f32x4 gg = *(const f32x4*)(g + 256 * j + 4 * lane); *(f32x4*)(xrow + 256 * j + 4 * lane) = v[j] * rs * gg; }
}
DI void unpack8(const u32x4 w, float* f) {
#pragma unroll
    for (int i = 0; i < 4; ++i) { f[2 * i] = __uint_as_float(w[i] << 16); f[2 * i + 1] = __uint_as_float(w[i] & 0xffff0000u); }
}
DI void sincos_acc(float ang, float& sn, float& cs) {
    const double xd = (double)ang; const double k = __builtin_rint(xd * 0.63661977236758134308);
    const float r = (float)(xd - k * 1.57079632679489661923); const int q = ((int)k) & 3; const float r2 = r * r;
    const float s = r + r * r2 * (-1.6666667e-1f + r2 * (8.3333333e-3f + r2 * (-1.9841270e-4f + r2 * 2.7557319e-6f)));
    const float c = 1.f + r2 * (-0.5f + r2 * (4.1666667e-2f + r2 * (-1.3888889e-3f + r2 * (2.4801587e-5f + r2 * -2.7557319e-7f))));
    sn = (q == 0) ? s : (q == 1) ? c : (q == 2) ? -s : -c;
    cs = (q == 0) ? c : (q == 1) ? -s : (q == 2) ? -c : s;
}

#ifndef PHMASK
#define PHMASK 0xFFFFFF
#endif
#define PH(k) ((PHMASK >> (k)) & 1)
#ifndef PHREP
#define PHREP 0x0
#endif
#define REP(k) for (int rep_ = 0; rep_ < (((PHREP >> (k)) & 1) ? 2 : 1); ++rep_)
constexpr int NPHASE = 14;
#ifndef MLA_SD
#define MLA_SD 1
#endif
__global__ void __launch_bounds__(512, 2) fwd_megakernel(Params P) {
    extern __shared__ __attribute__((aligned(16))) unsigned char lds[];
    cg::grid_group grid = cg::this_grid();
    const int G = gridDim.x, bid = blockIdx.x;
    LAS unsigned char* ring = (LAS unsigned char*)lds;
    if (threadIdx.x < 16) ((LAS unsigned*)(ring + MISC_OFF))[threadIdx.x] = 0u;
    __syncthreads();
    if (bid == 0) for (int i = threadIdx.x; i < (int)(CTL_BYTES + 32768) / 4; i += 512) __hip_atomic_store((unsigned*)(P.ws + WS_CTL) + i, 0u, __ATOMIC_RELAXED, __HIP_MEMORY_SCOPE_AGENT);
#define SEAM() xcd_barrier(xbar)
#define PHASE_VARS \
    const int tid = opaque_tid(), lane = tid & 63, wave = __builtin_amdgcn_readfirstlane(tid >> 6); const int gw = bid * 8 + wave, NGW = G * 8; (void)gw; (void)NGW; (void)lane; \
    size_t wz_ = 0; asm volatile("" : "+s"(wz_)); unsigned char* ws = P.ws + wz_;     \
    bf16 *Wt_in = (bf16*)(ws + WS_WIN), *Wt_mkv = (bf16*)(ws + WS_WMKV), *Wt_q = (bf16*)(ws + WS_WQ), *Wt_kv = (bf16*)(ws + WS_WKV), *Wt_out = (bf16*)(ws + WS_WOUT), \
         *Wt_mq = (bf16*)(ws + WS_WMQ), *Wt_mo = (bf16*)(ws + WS_WMO), *Wt_gu = (bf16*)(ws + WS_WGU), *Wt_dn = (bf16*)(ws + WS_WDN); \
    bf16 *HB = (bf16*)(ws + WS_HB), *MK = (bf16*)(ws + WS_MK), *MKV = (bf16*)(ws + WS_MKV), *KPE = (bf16*)(ws + WS_KPE), *OB = (bf16*)(ws + WS_OB), *OA = (bf16*)(ws + WS_OA), \
         *QKV = (bf16*)(ws + WS_QKV), *KVB = (bf16*)(ws + WS_KVB), *QB = (bf16*)(ws + WS_QB), *CQ = (bf16*)(ws + WS_CQ), *CKV = (bf16*)(ws + WS_CKV), \
         *MQ = (bf16*)(ws + WS_MQ), *MO = (bf16*)(ws + WS_MO), *GU = (bf16*)(ws + WS_GU); \
    float *TC = (float*)(ws + WS_TC), *TS = (float*)(ws + WS_TS), *LSE = (float*)(ws + WS_LSE), *SSQ = (float*)(ws + WS_SSQ), *SS1 = (float*)(ws + WS_SS1), *SS2 = (float*)(ws + WS_SS2), *SS3 = (float*)(ws + WS_SS3); \
    bf16 *XB1 = (bf16*)(ws + WS_XB1), *XB2 = (bf16*)(ws + WS_XB2), *X3 = (bf16*)(ws + WS_X3); (void)SS1; (void)SS2; (void)SS3; (void)XB1; (void)XB2; (void)X3; \
    (void)Wt_in; (void)Wt_mkv; (void)Wt_q; (void)Wt_kv; (void)Wt_out; (void)Wt_mq; (void)Wt_mo; (void)Wt_gu; (void)Wt_dn; (void)HB; (void)MK; (void)MKV; (void)KPE; (void)OB; (void)OA; \
    (void)QKV; (void)KVB; (void)QB; (void)CQ; (void)CKV; (void)MQ; (void)MO; (void)GU; (void)TC; (void)TS; (void)LSE; (void)SSQ;

    __syncthreads();
    grid.sync();
    const XcdBarrier xbar = xcd_barrier_post((unsigned*)(P.ws + WS_CTL), (volatile LAS unsigned*)(ring + MISC_OFF));
    if (PH(0)) REP(0) {
        PHASE_VARS
        LAS float* scr = (LAS float*)(ring + wave * 16384);
        constexpr int I0 = 16 * 72, I1 = 16 * 32, I2 = 6 * 24, I3 = 4 * 32, I4 = 16 * 32, I5 = 16 * 16, I6 = 8 * 32, I7 = 16 * 176, I8 = 44 * 32;
        constexpr int NITEMS = I0 + I1 + I2 + I3 + I4 + I5 + I6 + I7 + I8;
        for (int it = gw; it < NITEMS; it += NGW) {
            int r = it;
            if (r < I0) { const int g = r % 72, kb = r / 72; int sc;
                if (g < 64) sc = 32 * g; else if (g == 64) sc = 2048; else if (g == 65) sc = 2080; else if (g == 66) sc = 2176; else if (g == 67) sc = -1;
                else if (g == 68) sc = 2112; else if (g == 69) sc = 2144; else if (g == 70) sc = 2208; else sc = -1;
                transpose_item(P.w_in, 2240, sc, nullptr, Wt_in, 1024, 32 * g, 64 * kb, scr, lane); continue; } r -= I0;
            if (r < I1) { const int g = r % 32, kb = r / 32; transpose_item(P.w_mkv, 1024, 32 * g, nullptr, Wt_mkv, 1024, 32 * g, 64 * kb, scr, lane); continue; } r -= I1;
            if (r < I2) { const int g = r % 24, kb = r / 24; transpose_item(P.w_q_up, 768, 32 * g, P.q_norm, Wt_q, 384, 32 * g, 64 * kb, scr, lane); continue; } r -= I2;
            if (r < I3) { const int g = r % 32, kb = r / 32; transpose_item(P.w_kv_up, 1024, 32 * g, P.kv_norm, Wt_kv, 256, 32 * g, 64 * kb, scr, lane); continue; } r -= I3;
            if (r < I4) { const int g = r % 32, kb = r / 32; transpose_item(P.w_out, 1024, 32 * g, nullptr, Wt_out, 1024, 32 * g, 64 * kb, scr, lane); continue; } r -= I4;
            if (r < I5) { const int g = r % 16, kb = r / 16; transpose_item(P.w_mq, 512, 32 * g, P.norm_mem_q, Wt_mq, 1024, 32 * g, 64 * kb, scr, lane); continue; } r -= I5;
            if (r < I6) { const int g = r % 32, kb = r / 32; transpose_item(P.w_mo, 1024, 32 * g, nullptr, Wt_mo, 512, 32 * g, 64 * kb, scr, lane); continue; } r -= I6;
            if (r < I7) { const int g = r % 176, kb = r / 176; const int pn = g >> 3, bj = (g >> 2) & 1, q = g & 3;
                transpose_item(bj ? P.w_up : P.w_gate, DFF, 128 * pn + 32 * q, P.norm_ffn, Wt_gu, 1024, 32 * g, 64 * kb, scr, lane); continue; } r -= I7;
            { const int g = r % 32, kb = r / 32; transpose_item(P.w_down, 1024, 32 * g, nullptr, Wt_dn, DFF, 32 * g, 64 * kb, scr, lane); }
        }
        { int m = gw;
          for (; m + NGW < T; m += 2 * NGW) norm_row2_bf16(P.x + (size_t)m * 1024, P.x + (size_t)(m + NGW) * 1024, P.norm_mix, HB + (size_t)m * 1024, HB + (size_t)(m + NGW) * 1024, lane);
          for (; m < T; m += NGW) norm_row_bf16(P.x + (size_t)m * 1024, P.norm_mix, HB + (size_t)m * 1024, lane); }
        for (int m = gw; m < TM; m += NGW) norm_row_bf16(P.mem + (size_t)m * 1024, P.norm_mem_kv, MK + (size_t)m * 1024, lane);
        for (int e0 = bid * 512 + tid; e0 < T * 32; e0 += 4 * G * 512) {
            int pp[4];
#pragma unroll
            for (int j = 0; j < 4; ++j) { const int e = e0 + j * G * 512; pp[j] = (e < T * 32) ? P.pos[e >> 5] : 0; }
#pragma unroll
            for (int j = 0; j < 4; ++j) { const int e = e0 + j * G * 512; if (e < T * 32) { const int i = e & 31;
                const float inv = __builtin_exp2f(-(float)i * (13.287712379549449f / 32.f));
                const float ang = (float)pp[j] * inv; float sn, cs; sincos_acc(ang, sn, cs); TC[e] = cs; TS[e] = sn; } } }
        for (int e = bid * 512 + tid; e < 5 * T; e += G * 512) ((float*)(ws + WS_RS2))[e] = 0.f;
    }
    SEAM();
    if (PH(1)) REP(1) {
        PHASE_VARS
        { pg8::Gemm g{HB, Wt_in, T, DIN_PAD, 1024}; pg8::StaticOrder S; S.init(T, DIN_PAD, G, bid);
          epi::Proj E{QKV, CQ, CKV, KPE, (float*)(ws + WS_RS2 + 262144), TC, TS}; pg8::gemm_phase<epi::Proj, pg8::StaticOrder, true, true>(ring, g, S, E); }
        { pg8::Gemm g{MK, Wt_mkv, TM, 1024, 1024}; pg8::StaticOrder S; S.init(TM, 1024, G, (bid + G - 128) % G);
          epi::Plain E{MKV, 1024}; pg8::gemm_phase<epi::Plain, pg8::StaticOrder, true, true>(ring, g, S, E); }
    }
    SEAM();
    if (PH(2)) REP(2) {
        PHASE_VARS
        if (PH(16)) { pg8::Gemm g{CQ, Wt_q, T, 768, QLORA}; pg8::StaticOrder S; S.init(T, 768, G, bid);
          epi::Scaled<0, 0, 384, 2> E{QB, 768, (const float*)(ws + WS_RS2 + 262144)}; pg8::gemm_phase<epi::Scaled<0, 0, 384, 2>, pg8::StaticOrder, true, true>(ring, g, S, E); }
        if (PH(17)) { pg8::Gemm g{CKV, Wt_kv, T, 1024, KVLORA}; pg8::StaticOrder S; S.init(T, 1024, G, (bid + G - 128) % G);
          epi::Scaled<1, 0, 256, 2> E{KVB, 1024, (const float*)(ws + WS_RS2 + 262144)}; pg8::gemm_phase<epi::Scaled<1, 0, 256, 2>, pg8::StaticOrder, true, true>(ring, g, S, E); }
        if (PH(18)) for (int u = bid; u < 3072; u += G) {
            const int br = u >> 10, v = u & 1023, h = v & 7, w = v >> 3;
            const int b = w >> 4, blk = w & 15;
            int d, r, qb; if (br == 0) { d = 1; r = 0; qb = blk; } else if (br == 1) { d = 4; r = blk & 3; qb = blk >> 2; } else { d = 16; r = blk; qb = 0; }
            const float slope = __builtin_exp2f(-(float)(h + 1));
            dil::unit(QKV, P.pos, OA + (size_t)br * T * 512, LSE + (size_t)br * T * 8, b, h, d, r, qb, slope, (char*)lds);
        }
    }
    SEAM();
    if (PH(3)) REP(3) { PHASE_VARS
    for (int u = bid; u < 512; u += G) {
        const int bh = (u & 7) * 4 + (u >> 8) * 2 + (((u >> 3) & 31) >> 4), qb = (u >> 3) & 15, b = bh >> 2, h = bh & 3;
        const size_t t0 = (size_t)b * SEQ;
        att::dense_ring<4, 768, 1024, 128, 512>(QB + (t0 + qb * 256) * 768 + h * 192, KVB + t0 * 1024 + h * 256, KPE + t0 * 64, TC + (t0 + qb * 256) * 32, TS + (t0 + qb * 256) * 32,
                                           OB + (t0 + qb * 256) * 512 + h * 128, SEQ, 0.07216878364870323f, (char*)lds);
    } }
    SEAM();
    if (PH(4)) REP(4) { PHASE_VARS
    const int h = lane >> 3;
    const f32x4 ga0 = *(const f32x4*)(P.gout_a + 8 * lane), ga1 = *(const f32x4*)(P.gout_a + 8 * lane + 4), gb0 = *(const f32x4*)(P.gout_b + 8 * lane), gb1 = *(const f32x4*)(P.gout_b + 8 * lane + 4);
    for (int m = gw; m < T; m += 2 * NGW) {
        float l[2][3]; u32x4 r0[2], r1[2], r2[2], rb_[2];
#pragma unroll
        for (int j = 0; j < 2; ++j) { const int mj = (m + j * NGW < T) ? m + j * NGW : m;
            l[j][0] = LSE[(size_t)mj * 8 + h]; l[j][1] = LSE[(size_t)(T + mj) * 8 + h]; l[j][2] = LSE[(size_t)(2 * T + mj) * 8 + h];
            r0[j] = *(const u32x4*)(OA + (size_t)mj * 512 + 8 * lane); r1[j] = *(const u32x4*)(OA + (size_t)(T + mj) * 512 + 8 * lane); r2[j] = *(const u32x4*)(OA + (size_t)(2 * T + mj) * 512 + 8 * lane);
            rb_[j] = *(const u32x4*)(OB + (size_t)mj * 512 + 8 * lane); }
#pragma unroll
        for (int j = 0; j < 2; ++j) { const int mj = m + j * NGW;
            const float mx = fmaxf(l[j][0], fmaxf(l[j][1], l[j][2])); float w0 = __expf(l[j][0] - mx), w1 = __expf(l[j][1] - mx), w2 = __expf(l[j][2] - mx); const float inv = 1.f / (w0 + w1 + w2); w0 *= inv; w1 *= inv; w2 *= inv;
            float a0[8], a1[8], a2[8], ob[8], oa[8];
            unpack8(r0[j], a0); unpack8(r1[j], a1); unpack8(r2[j], a2); unpack8(rb_[j], ob);
            float sa = 0.f, sb = 0.f;
#pragma unroll
            for (int i = 0; i < 8; ++i) { oa[i] = w0 * a0[i] + w1 * a1[i] + w2 * a2[i]; sa += oa[i] * oa[i]; sb += ob[i] * ob[i]; }
            const float ra = __builtin_amdgcn_rsqf(wave_sum(sa) * (1.f / 512.f) + EPS), rb = __builtin_amdgcn_rsqf(wave_sum(sb) * (1.f / 512.f) + EPS);
            u32x4 wa, wb;
            wa.x = pk2(oa[0] * ra * ga0[0], oa[1] * ra * ga0[1]); wa.y = pk2(oa[2] * ra * ga0[2], oa[3] * ra * ga0[3]); wa.z = pk2(oa[4] * ra * ga1[0], oa[5] * ra * ga1[1]); wa.w = pk2(oa[6] * ra * ga1[2], oa[7] * ra * ga1[3]);
            wb.x = pk2(ob[0] * rb * gb0[0], ob[1] * rb * gb0[1]); wb.y = pk2(ob[2] * rb * gb0[2], ob[3] * rb * gb0[3]); wb.z = pk2(ob[4] * rb * gb1[0], ob[5] * rb * gb1[1]); wb.w = pk2(ob[6] * rb * gb1[2], ob[7] * rb * gb1[3]);
            if (mj < T) { *(u32x4*)(HB + (size_t)mj * 1024 + 8 * lane) = wa; *(u32x4*)(HB + (size_t)mj * 1024 + 512 + 8 * lane) = wb; } }
    } }
    SEAM();
    if (PH(5)) REP(5) { PHASE_VARS pg8::Gemm g{HB, Wt_out, T, 1024, 1024}; pg8::StaticOrder S; S.init(T, 1024, G, bid);
      epi::ResS<true, true> E{P.x, XB1, (float*)(ws + WS_RS2 + 131072)}; pg8::gemm_phase<epi::ResS<true, true>, pg8::StaticOrder, true, true>(ring, g, S, E); }
    SEAM();
    if (PH(7)) { PHASE_VARS pg8::Gemm g{XB1, Wt_mq, T, 512, 1024}; pg8::StaticOrder S; S.init(T, 512, G, bid);
      epi::Scaled<0, 0, 1024, 1> E{MQ, 512, (const float*)(ws + WS_RS2 + 131072)}; pg8::gemm_phase<epi::Scaled<0, 0, 1024, 1>, pg8::StaticOrder, true, true>(ring, g, S, E);
      if (G == 256) {
        asm volatile("s_waitcnt vmcnt(0)" ::: "memory"); __syncthreads();
        const int wg = (bid & 7) * 32 + (bid >> 3), pm = (wg >> 4) * 8 + (wg & 7), pn = (wg >> 3) & 1;
        for (int hs = 0; hs < 2; ++hs) { const int h = 2 * pn + hs, b = pm >> 4; const size_t t0 = (size_t)pm * 256;
          att::dense_ring<0, 512, 1024, 512, 512>(MQ + t0 * 512 + h * 128, MKV + (size_t)b * NMEM * 1024 + h * 128, nullptr, nullptr, nullptr,
                                                  MO + t0 * 512 + h * 128, NMEM, 0.08838834764831845f, (char*)lds); }
      }
    }
    if (G != 256) {
    SEAM();
    if (PH(8)) { PHASE_VARS
    for (int u = bid; u < 512; u += G) {
        const int h = u & 3, qb = (u >> 2) & 15, b = u >> 6; const size_t t0 = (size_t)b * SEQ + qb * 256;
        att::dense_ring<0, 512, 1024, 512, 512>(MQ + t0 * 512 + h * 128, MKV + (size_t)b * NMEM * 1024 + h * 128, nullptr, nullptr, nullptr,
                                           MO + t0 * 512 + h * 128, NMEM, 0.08838834764831845f, (char*)lds);
    } }
    }
    SEAM();
    if (PH(9)) REP(9) { PHASE_VARS pg8::Gemm g{MO, Wt_mo, T, 1024, 512}; pg8::StaticOrder S; S.init(T, 1024, G, bid);
      epi::ResS<false, true> E{XB1, XB2, (float*)(ws + WS_RS2)}; pg8::gemm_phase<epi::ResS<false, true>, pg8::StaticOrder, true, true>(ring, g, S, E); }
    SEAM();
    if (PH(11)) REP(11) { PHASE_VARS pg8::Gemm g{XB2, Wt_gu, T, 2 * DFF, 1024}; pg8::StaticOrder S; S.init(T, 2 * DFF, G, bid);
      epi::SwiGLU E{GU, (const float*)(ws + WS_RS2)}; pg8::gemm_phase<epi::SwiGLU, pg8::StaticOrder, true, true>(ring, g, S, E); }
    SEAM();
    const bool fuse_final = (G == 256);
    if (PH(12)) { PHASE_VARS pg8::Gemm g{GU, Wt_dn, T, 1024, DFF}; pg8::StaticOrder S; S.init(T, 1024, G, bid);
      if (fuse_final) { epi::ResFinal E{XB2, P.out, (float*)(ws + WS_RS2 + 524288), (unsigned*)(ws + WS_PCNT), P.norm_final}; pg8::gemm_phase<epi::ResFinal, pg8::StaticOrder, true, true>(ring, g, S, E); }
      else { epi::ResS<false> E{XB2, X3, SS3}; pg8::gemm_phase<epi::ResS<false>, pg8::StaticOrder, true, true>(ring, g, S, E); } }
    if (fuse_final) return;
    SEAM();
    if (PH(13)) { PHASE_VARS
    for (int m = gw; m < T; m += NGW) {
        float ss = 0.f;
#pragma unroll
        for (int q = 0; q < 4; ++q) { const f32x4 v = *(const f32x4*)(SS3 + (size_t)m * 16 + 4 * q); ss += (v[0] + v[1]) + (v[2] + v[3]); }
        const float rs = __builtin_amdgcn_rsqf(ss * (1.f / 1024.f) + EPS);
#pragma unroll
        for (int hf = 0; hf < 2; ++hf) { float xv[8]; unpack8(*(const u32x4*)(X3 + (size_t)m * 1024 + hf * 512 + 8 * lane), xv);
            const f32x4 g0 = *(const f32x4*)(P.norm_final + hf * 512 + 8 * lane), g1 = *(const f32x4*)(P.norm_final + hf * 512 + 8 * lane + 4);
            *(f32x4*)(P.out + (size_t)m * 1024 + hf * 512 + 8 * lane) = (f32x4){xv[0] * rs * g0[0], xv[1] * rs * g0[1], xv[2] * rs * g0[2], xv[3] * rs * g0[3]};
            *(f32x4*)(P.out + (size_t)m * 1024 + hf * 512 + 8 * lane + 4) = (f32x4){xv[4] * rs * g1[0], xv[5] * rs * g1[1], xv[6] * rs * g1[2], xv[7] * rs * g1[3]}; }
    } }
}

extern "C" void kernel_launch(void* const* d_in, const int* in_sizes, int n_in, void* d_out, int out_size, void* d_ws, size_t ws_size, hipStream_t stream) {
    static int grid_blocks = 0;
    if (grid_blocks == 0) {
        if (n_in != 22 || in_sizes[0] != T * DM || out_size != T * DM || ws_size < WS_END) {
            fprintf(stderr, "kernel_launch: shape mismatch n_in %d in0 %d out %d ws %zu (need %zu)\n", n_in, n_in > 0 ? in_sizes[0] : -1, out_size, ws_size, (size_t)WS_END); grid_blocks = -1; return; }
        int dev = 0, cus = 0, per_cu = 0;
        hipGetDevice(&dev); hipDeviceGetAttribute(&cus, hipDeviceAttributeMultiprocessorCount, dev);
        if (hipFuncSetAttribute((const void*)fwd_megakernel, hipFuncAttributeMaxDynamicSharedMemorySize, LDS_BYTES) != hipSuccess) { fprintf(stderr, "kernel_launch: hipFuncSetAttribute failed\n"); grid_blocks = -1; return; }
        if (hipOccupancyMaxActiveBlocksPerMultiprocessor(&per_cu, (const void*)fwd_megakernel, 512, LDS_BYTES) != hipSuccess || per_cu < 1) { fprintf(stderr, "kernel_launch: occupancy query failed (%d)\n", per_cu); per_cu = 1; }
        (void)hipGetLastError();
        grid_blocks = cus * (per_cu > 1 ? 1 : per_cu);
        if (grid_blocks % 8 != 0 || grid_blocks < 136) fprintf(stderr, "kernel_launch: unexpected grid %d\n", grid_blocks);
    }
    if (grid_blocks < 0) return;
    Params p{};
    p.x = (const float*)d_in[0]; p.mem = (const float*)d_in[1]; p.pos = (const int*)d_in[2];
    p.norm_mix = (const float*)d_in[3]; p.w_in = (const float*)d_in[4]; p.q_norm = (const float*)d_in[5]; p.w_q_up = (const float*)d_in[6]; p.kv_norm = (const float*)d_in[7];
    p.w_kv_up = (const float*)d_in[8]; p.gout_a = (const float*)d_in[9]; p.gout_b = (const float*)d_in[10]; p.w_out = (const float*)d_in[11]; p.norm_mem_q = (const float*)d_in[12];
    p.norm_mem_kv = (const float*)d_in[13]; p.w_mq = (const float*)d_in[14]; p.w_mkv = (const float*)d_in[15]; p.w_mo = (const float*)d_in[16]; p.norm_ffn = (const float*)d_in[17];
    p.w_gate = (const float*)d_in[18]; p.w_up = (const float*)d_in[19]; p.w_down = (const float*)d_in[20]; p.norm_final = (const float*)d_in[21];
    p.out = (float*)d_out; p.ws = (unsigned char*)d_ws;
    void* args[] = {&p};
    hipError_t e = hipLaunchCooperativeKernel((const void*)fwd_megakernel, dim3(grid_blocks), dim3(512), args, LDS_BYTES, stream);
    if (e != hipSuccess) fprintf(stderr, "cooperative launch failed: %s (grid %d)\n", hipGetErrorString(e), grid_blocks);
}
```
